# Optimizing an MI355X kernel written in HIP

```python
import math
import jax, jax.numpy as jnp
from jax import lax
import numpy as np

D_MODEL = 1024
BATCH = 4
SEQ = 8192
DEPTH = 1

HG_HEADS = 4
HG_DIM = 128
HG_WIDTH = HG_HEADS * HG_DIM
HG_CHUNK = 64
AT_HEADS = 8
AT_KV_GROUPS = 2
AT_HEAD_DIM = 64
AT_WIDTH = AT_HEADS * AT_HEAD_DIM
AT_KV_WIDTH = AT_KV_GROUPS * AT_HEAD_DIM
Q_LORA = 256
IDX_HEADS = 8
IDX_DIM = 64
TOPK_MAX = 256
Q_BLOCK = 128
REL_BUCKETS = 32
REL_MAX_DIST = 128
D_FF = 4 * D_MODEL
EPS = 1e-6

IN_WIDTHS = (HG_WIDTH, HG_WIDTH, HG_WIDTH, HG_WIDTH,
             Q_LORA, AT_KV_WIDTH, AT_KV_WIDTH,
             IDX_DIM, IDX_HEADS,
             D_MODEL, D_MODEL)
IN_COLS = sum(IN_WIDTHS)

kernel_name = "hybrid_hgrn2_dsa_gated_block"


def _split_points():
    pts, acc = [], 0
    for w in IN_WIDTHS[:-1]:
        acc += w
        pts.append(acc)
    return tuple(pts)


def rms_norm(x, g):
    xf = x.astype(jnp.float32)
    y = xf * lax.rsqrt(jnp.mean(xf * xf, axis=-1, keepdims=True) + EPS)
    return (y * g.astype(jnp.float32)).astype(x.dtype)


def layer_norm(x, g, b):
    xf = x.astype(jnp.float32)
    mu = jnp.mean(xf, axis=-1, keepdims=True)
    var = jnp.mean(jnp.square(xf - mu), axis=-1, keepdims=True)
    y = (xf - mu) * lax.rsqrt(var + EPS)
    return (y * g.astype(jnp.float32) + b.astype(jnp.float32)).astype(x.dtype)


def hgrn2_lower_bounds(lb_logits):
    p = jax.nn.softmax(lb_logits.astype(jnp.float32), axis=0)
    return jnp.cumsum(p, axis=0)


def hgrn2_mixer(q, f_logit, i, lb):
    B, T, _ = q.shape
    C = HG_CHUNK
    n = T // C
    f = lb + (1.0 - lb) * jax.nn.sigmoid(f_logit.astype(jnp.float32))
    log_f = jnp.log(f)
    k = 1.0 - f

    def to_chunks(a):
        return a.astype(jnp.float32).reshape(B, n, C, HG_HEADS, HG_DIM).transpose(1, 0, 3, 2, 4)

    qc, kc, vc, gc = to_chunks(q), to_chunks(k), to_chunks(i), to_chunks(log_f)
    causal = jnp.tril(jnp.ones((C, C), dtype=bool))[:, :, None]

    def step(S, inp):
        qt, kt, vt, gt = inp
        b = jnp.cumsum(gt, axis=2)
        o_inter = jnp.einsum('bhtd,bhde->bhte', qt * jnp.exp(b), S)
        diff = b[:, :, :, None, :] - b[:, :, None, :, :]
        decay = jnp.exp(jnp.where(causal, diff, -jnp.inf))
        A = jnp.einsum('bhtd,bhsd,bhtsd->bhts', qt, kt, decay)
        o = o_inter + jnp.einsum('bhts,bhse->bhte', A, vt)
        b_last = b[:, :, -1:, :]
        S = jnp.exp(b_last[:, :, 0, :])[..., None] * S + \
            jnp.einsum('bhsd,bhse->bhde', kt * jnp.exp(b_last - b), vt)
        return S, o

    S0 = jnp.zeros((B, HG_HEADS, HG_DIM, HG_DIM), jnp.float32)
    _, o = lax.scan(step, S0, (qc, kc, vc, gc))
    return o.transpose(1, 0, 3, 2, 4).reshape(B, T, HG_WIDTH)


def t5_bucket(dist):
    max_exact = REL_BUCKETS // 2
    large = max_exact + (jnp.log(jnp.maximum(dist, 1).astype(jnp.float32) / max_exact)
                         / math.log(REL_MAX_DIST / max_exact)
                         * (REL_BUCKETS - max_exact)).astype(jnp.int32)
    large = jnp.minimum(large, REL_BUCKETS - 1)
    return jnp.where(dist < max_exact, dist, large)


def dsa_mixer(q, q_idx, w_idx, k, v, k_idx, rel_bias):
    B, T, _ = q.shape
    G, R, dh = AT_KV_GROUPS, AT_HEADS // AT_KV_GROUPS, AT_HEAD_DIM
    topk = min(TOPK_MAX, T // 4)
    nb = T // Q_BLOCK
    qb_all = q.reshape(B, nb, Q_BLOCK, G, R, dh).transpose(1, 0, 2, 3, 4, 5)
    qi_all = q_idx.reshape(B, nb, Q_BLOCK, IDX_HEADS, IDX_DIM).transpose(1, 0, 2, 3, 4)
    wi_all = w_idx.reshape(B, nb, Q_BLOCK, IDX_HEADS).transpose(1, 0, 2, 3)
    pos_all = jnp.arange(T, dtype=jnp.int32).reshape(nb, Q_BLOCK)
    key_pos = jnp.arange(T, dtype=jnp.int32)
    gather = jax.vmap(lambda a, ix: a[ix])

    def block(inp):
        qb, qib, wb, tpos = inp
        rel = jax.nn.relu(jnp.einsum('bqhd,bsd->bqhs', qib, k_idx).astype(jnp.float32) * (IDX_DIM ** -0.5))
        score = jnp.einsum('bqh,bqhs->bqs', wb.astype(jnp.float32) * (IDX_HEADS ** -0.5), rel)
        causal = key_pos[None, :] <= tpos[:, None]
        score = jnp.where(causal[None], score, -jnp.inf)
        _, idx = lax.top_k(score, topk)
        kg = gather(k, idx)
        vg = gather(v, idx)
        logits = jnp.einsum('bqgrd,bqkgd->bqgrk', qb, kg).astype(jnp.float32) * (dh ** -0.5)
        dist = tpos[None, :, None] - idx
        bias = rel_bias[t5_bucket(jnp.maximum(dist, 0))]
        bias = bias.reshape(B, Q_BLOCK, topk, G, R).transpose(0, 1, 3, 4, 2).astype(jnp.float32)
        valid = (dist >= 0)[:, :, None, None, :]
        logits = jnp.where(valid, logits + bias, -jnp.inf)
        p = jax.nn.softmax(logits, axis=-1).astype(v.dtype)
        o = jnp.einsum('bqgrk,bqkgd->bqgrd', p, vg)
        return o.reshape(B, Q_BLOCK, AT_WIDTH)

    out = lax.map(block, (qb_all, qi_all, wi_all, pos_all))
    return out.transpose(1, 0, 2, 3).reshape(B, T, AT_WIDTH)


def setup_inputs(seed: int = 0) -> dict:
    key = jax.random.key(seed)
    ks = jax.random.split(key, 20)
    f32 = jnp.float32

    def w(k, shape, fan_in):
        return jax.random.normal(k, shape, f32) * (fan_in ** -0.5)

    def gain(k, shape):
        return 1.0 + 0.02 * jax.random.normal(k, shape, f32)

    return {
        "x": jax.random.normal(ks[0], (BATCH, SEQ, D_MODEL), f32),
        "attn_norm_g": gain(ks[1], (DEPTH, D_MODEL)),
        "w_in": w(ks[2], (DEPTH, D_MODEL, IN_COLS), D_MODEL),
        "hgrn_lb_logits": jax.random.normal(ks[3], (DEPTH + 1, HG_WIDTH), f32),
        "hgrn_norm_g": gain(ks[4], (DEPTH, HG_WIDTH)),
        "w_up_hgrn": w(ks[5], (DEPTH, HG_WIDTH, D_MODEL), HG_WIDTH),
        "q_norm_g": gain(ks[6], (DEPTH, Q_LORA)),
        "w_uq": w(ks[7], (DEPTH, Q_LORA, AT_WIDTH), Q_LORA),
        "w_iq": w(ks[8], (DEPTH, Q_LORA, IDX_HEADS * IDX_DIM), Q_LORA),
        "idx_k_norm_g": gain(ks[9], (DEPTH, IDX_DIM)),
        "idx_k_norm_b": 0.02 * jax.random.normal(ks[10], (DEPTH, IDX_DIM), f32),
        "rel_bias": 0.5 * jax.random.normal(ks[11], (REL_BUCKETS, AT_HEADS), f32),
        "w_up_attn": w(ks[12], (DEPTH, AT_WIDTH, D_MODEL), AT_WIDTH),
        "w_o": w(ks[13], (DEPTH, D_MODEL, D_MODEL), D_MODEL),
        "mlp_norm_g": gain(ks[14], (DEPTH, D_MODEL)),
        "w_mlp_in": w(ks[15], (DEPTH, D_MODEL, D_FF), D_MODEL),
        "w_mlp_out": w(ks[16], (DEPTH, D_FF, D_MODEL), D_FF),
        "final_norm_g": gain(ks[17], (D_MODEL,)),
    }


def reference(x, attn_norm_g, w_in, hgrn_lb_logits, hgrn_norm_g, w_up_hgrn, q_norm_g, w_uq,
              w_iq, idx_k_norm_g, idx_k_norm_b, rel_bias, w_up_attn, w_o, mlp_norm_g,
              w_mlp_in, w_mlp_out, final_norm_g):
    B, T, _ = x.shape
    splits = _split_points()
    lbs = hgrn2_lower_bounds(hgrn_lb_logits)
    for l in range(DEPTH):
        h = rms_norm(x, attn_norm_g[l])
        proj = h @ w_in[l]
        (hq, hf, hi, hg, cq, ak, av, ik, iw, gate_a, gate_b) = jnp.split(proj, splits, axis=-1)

        oa = hgrn2_mixer(hq, hf, hi, lbs[l]).astype(x.dtype)
        oa = rms_norm(oa.reshape(B, T, HG_HEADS, HG_DIM),
                      hgrn_norm_g[l].reshape(HG_HEADS, HG_DIM)).reshape(B, T, HG_WIDTH)
        oa = oa * jax.nn.silu(hg)

        cq = rms_norm(cq, q_norm_g[l])
        aq = cq @ w_uq[l]
        iq = cq @ w_iq[l]
        ik = layer_norm(ik, idx_k_norm_g[l], idx_k_norm_b[l])
        ob = dsa_mixer(aq, iq, iw,
                       ak.reshape(B, T, AT_KV_GROUPS, AT_HEAD_DIM),
                       av.reshape(B, T, AT_KV_GROUPS, AT_HEAD_DIM),
                       ik, rel_bias)

        mix = jax.nn.sigmoid(gate_a) * (oa @ w_up_hgrn[l]) + jax.nn.sigmoid(gate_b) * (ob @ w_up_attn[l])
        x = x + mix @ w_o[l]

        hm = rms_norm(x, mlp_norm_g[l])
        x = x + jnp.square(jax.nn.relu(hm @ w_mlp_in[l])) @ w_mlp_out[l]
    return rms_norm(x, final_norm_g)
```

```cpp
#define MK_N_LAUNCHES 12
#include <hip/hip_runtime.h>
#include <cstdio>
#include <cstdint>
namespace pg8 {
#define PG8_LAS __attribute__((address_space(3)))
typedef unsigned short bf16_t;
typedef short bf16x8 __attribute__((ext_vector_type(8)));
typedef float f32x4 __attribute__((ext_vector_type(4)));
typedef unsigned u32x4 __attribute__((ext_vector_type(4)));
constexpr int BM = 256, BK = 64, HALF = 128, HTB = HALF * BK * 2  , STAGE_BYTES = 8 * HTB, NXCD = 8, WGM = 8;

__host__ __device__ __forceinline__ int lds_byte(int r, int c) { const int st = (r >> 4) * 2 + (c >> 5), rr = r & 15, cc = c & 31, ob = rr * 64 + cc * 2; return st * 1024 + (ob ^ (((ob >> 9) & 1) << 5)); }
__host__ __device__ __forceinline__ void stage_rc(int b, int& R, int& C) { const int st = b / 1024, sb = b % 1024, swz = sb ^ (((sb >> 9) & 1) << 5); R = (st >> 1) * 16 + swz / 64; C = (st & 1) * 32 + (swz % 64) / 2; }
__host__ __device__ __forceinline__ int perm32(int rho) { const int n = rho >> 4, i = rho & 15; return 8 * (i >> 2) + 4 * n + (i & 3); }

struct Unit { int pm, pn; };
struct Gemm { const bf16_t* A; const bf16_t* Bt; int M, N, K; };

struct StaticOrder {
    int nM, nN, nwg, G, c;
    __host__ __device__ void init(int M, int N, int G_, int c_) { nM = M / BM; nN = N / BM; nwg = nM * nN; G = G_; c = c_; }
    __host__ __device__ bool next(int i, Unit& u) const {
        const long L = (long)i * G + c; if (L >= nwg) return false;
        int wgid = (int)L; { const int q = nwg / NXCD, r = nwg % NXCD, xcd = wgid % NXCD, off = wgid / NXCD; wgid = (xcd < r ? xcd * (q + 1) : r * (q + 1) + (xcd - r) * q) + off; }
        const int nig = WGM * nN, gid = wgid / nig, fm = gid * WGM, gsz = (nM - fm) < WGM ? (nM - fm) : WGM;
        u.pm = fm + ((wgid % nig) % gsz); u.pn = (wgid % nig) / gsz; return true;
    }
    __device__ __forceinline__ void a_ready(const Unit&) const {}
    __device__ __forceinline__ void done(const Unit&) const {}
};
typedef __bf16 bf16x2_t __attribute__((ext_vector_type(2)));
typedef float f32x2_t __attribute__((ext_vector_type(2)));
__device__ __forceinline__ unsigned cvt_pk_bf16(float lo, float hi) { const f32x2_t v = {lo, hi}; const bf16x2_t b = __builtin_convertvector(v, bf16x2_t); return __builtin_bit_cast(unsigned, b); }
typedef float f32x2 __attribute__((ext_vector_type(2)));
template <class Epi, class Sched, bool ALIGN_EPI = false, bool SP2 = false>
__device__ __forceinline__ void gemm_phase(PG8_LAS unsigned char* lds, const Gemm g, const Sched& S, const Epi& E) {
    const int tid = threadIdx.x, wid = __builtin_amdgcn_readfirstlane(tid >> 6), lane = tid & 63, wr = wid >> 2, wc = wid & 3, fr = lane & 15, fq = lane >> 4;
    const int K = g.K, nt = K / BK;
    unsigned voffA[2], voffB[2];
#pragma unroll
    for (int i = 0; i < 2; ++i) { int R, C; stage_rc(tid * 16 + i * 8192, R, C); const int Rb = Epi::PERM ? ((R & ~31) + perm32(R & 31)) : R;
        voffA[i] = (unsigned)(R * K + C) * 2u; voffB[i] = (unsigned)(Rb * K + C) * 2u; }
    const size_t kstep = (size_t)(BK * 2);
    const size_t hstep = (size_t)HALF * K * 2;
    const size_t tstep = 2 * hstep;
    const unsigned ldsw = (unsigned)wid * 1024u;
    const int aoff = lds_byte(wr * 64 + fr, fq * 8), boff = lds_byte(wc * 32 + fr, fq * 8);
#define PG8_SA(b, h) (((b) * 2 + (h)) * HTB)
#define PG8_SB(b, h) ((4 + (b) * 2 + (h)) * HTB)
#define PG8_STAGE(bufoff, gbase, voff) do { _Pragma("unroll") for (int _i = 0; _i < 2; ++_i) \
        __builtin_amdgcn_global_load_lds((const unsigned*)((const char*)(gbase) + (voff)[_i]), (PG8_LAS unsigned*)(lds + (bufoff) + ldsw + _i * 8192), 16, 0, 0); } while (0)
#define PG8_LDA(dst, b, h) do { _Pragma("unroll") for (int m = 0; m < 4; ++m) _Pragma("unroll") for (int k = 0; k < 2; ++k) dst[m][k] = *(const PG8_LAS bf16x8*)(lds + PG8_SA(b, h) + aoff + m * 2048 + k * 1024); } while (0)
#define PG8_LDB(dst, b, h) do { _Pragma("unroll") for (int n = 0; n < 2; ++n) _Pragma("unroll") for (int k = 0; k < 2; ++k) dst[n][k] = *(const PG8_LAS bf16x8*)(lds + PG8_SB(b, h) + boff + n * 2048 + k * 1024); } while (0)
#define PG8_MMA(ai, bj, At, Bt) do { __builtin_amdgcn_s_setprio(1); _Pragma("unroll") for (int m = 0; m < 4; ++m) _Pragma("unroll") for (int n = 0; n < 2; ++n) _Pragma("unroll") for (int k = 0; k < 2; ++k) \
        acc[ai][bj][m][n] = __builtin_amdgcn_mfma_f32_16x16x32_bf16(Bt[n][k], At[m][k], acc[ai][bj][m][n], 0, 0, 0); __builtin_amdgcn_s_setprio(0); } while (0)
#define PG8_WAIT_V(n) asm volatile("s_waitcnt vmcnt(" #n ")" ::: "memory")
#define PG8_WAIT_L(n) asm volatile("s_waitcnt lgkmcnt(" #n ")" ::: "memory")
#define PG8_BAR __builtin_amdgcn_s_barrier()
#define PG8_SCHED __builtin_amdgcn_sched_barrier(0)
    Unit cur, nxt; int ui = 0;
    if (!S.next(0, cur)) return;
    f32x4 acc[2][2][4][2];
#pragma unroll
    for (int a = 0; a < 2; ++a)
#pragma unroll
        for (int b = 0; b < 2; ++b)
#pragma unroll
            for (int m = 0; m < 4; ++m)
#pragma unroll
                for (int n = 0; n < 2; ++n) acc[a][b][m][n] = (f32x4){0.f, 0.f, 0.f, 0.f};
    bf16x8 At[4][2], B0[2][2], B1[2][2];
    const char* cA = (const char*)g.A + (size_t)cur.pm * tstep; const char* cB = (const char*)g.Bt + (size_t)cur.pn * tstep;
    S.a_ready(cur);
    if constexpr (SP2) {
        PG8_STAGE(PG8_SB(0, 0), cB, voffB); PG8_STAGE(PG8_SB(0, 1), cB + hstep, voffB); PG8_STAGE(PG8_SA(0, 0), cA, voffA); PG8_STAGE(PG8_SA(0, 1), cA + hstep, voffA);
        if (wr == 1) PG8_BAR;
        PG8_WAIT_V(2); PG8_BAR;
        PG8_STAGE(PG8_SB(1, 0), cB + kstep, voffB); PG8_STAGE(PG8_SA(1, 0), cA + kstep, voffA); PG8_STAGE(PG8_SB(1, 1), cB + hstep + kstep, voffB);
        PG8_WAIT_V(6); PG8_BAR;
    } else {
        PG8_STAGE(PG8_SB(0, 0), cB, voffB); PG8_STAGE(PG8_SA(0, 0), cA, voffA); PG8_STAGE(PG8_SB(0, 1), cB + hstep, voffB); PG8_STAGE(PG8_SA(0, 1), cA + hstep, voffA);
        if (wr == 1) PG8_BAR;
        PG8_WAIT_V(4); PG8_BAR;
        PG8_STAGE(PG8_SB(1, 0), cB + kstep, voffB); PG8_STAGE(PG8_SA(1, 0), cA + kstep, voffA); PG8_STAGE(PG8_SB(1, 1), cB + hstep + kstep, voffB);
        PG8_WAIT_V(6); PG8_BAR;
    }
    for (;;) {
        const bool has_next = S.next(ui + 1, nxt);
        const char* nA = has_next ? (const char*)g.A + (size_t)nxt.pm * tstep : cA; const char* nB = has_next ? (const char*)g.Bt + (size_t)nxt.pn * tstep : cB;
        _Pragma("unroll 1") for (int t = 0; t < nt; t += 2) {
            const bool last = (t == nt - 2);
            const char* a1 = cA + (size_t)(t + 1) * kstep;
            const char* a2 = last ? nA : cA + (size_t)(t + 2) * kstep; const char* b2 = last ? nB : cB + (size_t)(t + 2) * kstep;
            const char* a3 = a2 + kstep; const char* b3 = b2 + kstep;
            if (last && has_next) S.a_ready(nxt);
            if constexpr (SP2) {
            PG8_LDB(B0, 0, 0); PG8_LDB(B1, 0, 1); PG8_SCHED; PG8_LDA(At, 0, 0); PG8_STAGE(PG8_SA(1, 1), a1 + hstep, voffA);
            PG8_WAIT_V(8); PG8_WAIT_L(0); PG8_BAR; PG8_MMA(0, 0, At, B0); PG8_MMA(0, 1, At, B1); PG8_BAR; PG8_SCHED;
            PG8_LDA(At, 0, 1); PG8_STAGE(PG8_SB(0, 0), b2, voffB); PG8_STAGE(PG8_SB(0, 1), b2 + hstep, voffB); PG8_STAGE(PG8_SA(0, 0), a2, voffA);
            PG8_WAIT_V(8); PG8_WAIT_L(0); PG8_BAR; PG8_MMA(1, 0, At, B0); PG8_MMA(1, 1, At, B1); PG8_BAR; PG8_SCHED;
            PG8_LDB(B0, 1, 0); PG8_LDB(B1, 1, 1); PG8_SCHED; PG8_LDA(At, 1, 0); PG8_STAGE(PG8_SA(0, 1), a2 + hstep, voffA);
            PG8_WAIT_V(8); PG8_WAIT_L(0); PG8_BAR; PG8_MMA(0, 0, At, B0); PG8_MMA(0, 1, At, B1); PG8_BAR; PG8_SCHED;
            PG8_LDA(At, 1, 1); PG8_STAGE(PG8_SB(1, 0), b3, voffB); PG8_STAGE(PG8_SB(1, 1), b3 + hstep, voffB); PG8_STAGE(PG8_SA(1, 0), a3, voffA);
            PG8_WAIT_V(8); PG8_WAIT_L(0); PG8_BAR; PG8_MMA(1, 0, At, B0); PG8_MMA(1, 1, At, B1); PG8_BAR; PG8_SCHED;
            } else {
            PG8_LDB(B0, 0, 0); PG8_SCHED; PG8_LDA(At, 0, 0); PG8_STAGE(PG8_SA(1, 1), a1 + hstep, voffA);
            PG8_WAIT_L(8); PG8_BAR; PG8_WAIT_L(0); PG8_MMA(0, 0, At, B0); PG8_BAR; PG8_SCHED;
            PG8_LDB(B1, 0, 1); PG8_STAGE(PG8_SB(0, 0), b2, voffB);
            PG8_BAR; PG8_WAIT_L(0); PG8_MMA(0, 1, At, B1); PG8_BAR;
            PG8_LDA(At, 0, 1); PG8_STAGE(PG8_SA(0, 0), a2, voffA);
            PG8_BAR; PG8_WAIT_L(0); PG8_MMA(1, 0, At, B0); PG8_BAR; PG8_SCHED;
            PG8_STAGE(PG8_SB(0, 1), b2 + hstep, voffB);
            PG8_WAIT_V(6); PG8_BAR; PG8_MMA(1, 1, At, B1); PG8_BAR;
            PG8_LDB(B0, 1, 0); PG8_SCHED; PG8_LDA(At, 1, 0); PG8_STAGE(PG8_SA(0, 1), a2 + hstep, voffA);
            PG8_WAIT_L(8); PG8_BAR; PG8_WAIT_L(0); PG8_MMA(0, 0, At, B0); PG8_BAR; PG8_SCHED;
            PG8_LDB(B1, 1, 1); PG8_STAGE(PG8_SB(1, 0), b3, voffB);
            PG8_BAR; PG8_WAIT_L(0); PG8_MMA(0, 1, At, B1); PG8_BAR;
            PG8_LDA(At, 1, 1); PG8_STAGE(PG8_SA(1, 0), a3, voffA);
            PG8_BAR; PG8_WAIT_L(0); PG8_MMA(1, 0, At, B0); PG8_BAR; PG8_SCHED;
            PG8_STAGE(PG8_SB(1, 1), b3 + hstep, voffB);
            PG8_WAIT_V(6); PG8_BAR; PG8_MMA(1, 1, At, B1); PG8_BAR;
            }
        }
        if constexpr (ALIGN_EPI) { if (wr == 0) PG8_BAR; }
        if constexpr (!Epi::AFTER_DRAIN) { E(acc, cur, wr, wc, fr, fq); S.done(cur); }
        if (!has_next) break;
#pragma unroll
        for (int a = 0; a < 2; ++a)
#pragma unroll
            for (int b = 0; b < 2; ++b)
#pragma unroll
                for (int m = 0; m < 4; ++m)
#pragma unroll
                    for (int n = 0; n < 2; ++n) acc[a][b][m][n] = (f32x4){0.f, 0.f, 0.f, 0.f};
        cur = nxt; cA = nA; cB = nB; ++ui;
        if constexpr (ALIGN_EPI) { if (wr == 1) PG8_BAR; }
    }
    PG8_WAIT_V(0);
    if constexpr (!ALIGN_EPI) { if (wr == 0) PG8_BAR; }
    PG8_BAR;
    if constexpr (Epi::AFTER_DRAIN) { E.fused(acc, cur, wr, wc, fr, fq, lds, wid, lane); S.done(cur); }
#undef PG8_SA
#undef PG8_SB
#undef PG8_STAGE
#undef PG8_LDA
#undef PG8_LDB
#undef PG8_MMA
#undef PG8_WAIT_V
#undef PG8_WAIT_L
#undef PG8_BAR
#undef PG8_SCHED
}
}

#ifndef MK_N_LAUNCHES
#define MK_N_LAUNCHES 1
#endif
#ifndef DBG_SKIP_HGRN
#define DBG_SKIP_HGRN 0
#endif
#ifndef P1_ALIGN
#define P1_ALIGN true
#endif
#ifndef P1_SP2
#define P1_SP2 true
#endif
#ifndef DBG_SKIP_DSA
#define DBG_SKIP_DSA 0
#endif

#define GAS __attribute__((address_space(1)))
#define LAS __attribute__((address_space(3)))
typedef unsigned short bf16;
typedef unsigned v4u __attribute__((ext_vector_type(4)));
typedef unsigned v2u __attribute__((ext_vector_type(2)));
typedef float f32x4 __attribute__((ext_vector_type(4)));
typedef short bf16x8 __attribute__((ext_vector_type(8)));
typedef _Float16 h2 __attribute__((ext_vector_type(2)));
typedef _Float16 h8 __attribute__((ext_vector_type(8)));
typedef GAS unsigned gu32;

constexpr int NWAVES = 8, NTHR = 512;
constexpr int BATCH = 4, SEQ = 8192, DM = 1024, M = BATCH * SEQ;
constexpr int HGW = 512, HGD = 128;
constexpr int NPROJ = 4864;
constexpr int DFF = 4096;
constexpr float EPS = 1e-6f;
constexpr int NPHASE = 12;

constexpr size_t MiB = 1u << 20;
constexpr size_t WS_CTL = 0, CTL_ZERO_BYTES = 1 * MiB;
constexpr size_t WS_WIN = 1 * MiB;
constexpr size_t WS_LB = 10 * MiB + 768 * 1024;
constexpr size_t WS_WQI = 11 * MiB;
constexpr size_t WS_WMH = 12 * MiB;
constexpr size_t WS_WMA = 13 * MiB;
constexpr size_t WS_WO = 14 * MiB;
constexpr size_t WS_WMI = 16 * MiB;
constexpr size_t WS_WMO = 24 * MiB;
constexpr size_t WS_GA = 32 * MiB;
constexpr size_t WS_GB = 96 * MiB;
constexpr size_t WS_QH = 160 * MiB;
constexpr size_t WS_G = 192 * MiB;
constexpr size_t WS_VH = 256 * MiB;
constexpr size_t WS_SG = 288 * MiB;
constexpr size_t WS_CQ = 320 * MiB;
constexpr size_t WS_OB = 320 * MiB;
constexpr size_t WS_KV = 352 * MiB;
constexpr size_t WS_IKW = 368 * MiB;
constexpr size_t WS_CQN = 384 * MiB;
constexpr size_t WS_IKN = 400 * MiB;
constexpr size_t WS_HM = 416 * MiB;
constexpr size_t WS_AQ = 416 * MiB;
constexpr size_t WS_IQ = 448 * MiB;
constexpr size_t WS_MIX = 416 * MiB;
constexpr size_t WS_OA = 480 * MiB;
constexpr size_t WS_MIXP = 160 * MiB;
constexpr size_t WS_HID = 160 * MiB;
constexpr size_t WS_END = 512 * MiB;

constexpr int CW_Q = 64;
constexpr int CW_BAR = 4096;

constexpr int LDS_BYTES = 163840 - 1024;
constexpr int MISC_OFF = LDS_BYTES - 256;

#define LDS_WAIT() asm volatile("s_waitcnt lgkmcnt(0)" ::: "memory")
#define VM_WAIT() asm volatile("s_waitcnt vmcnt(0)" ::: "memory")
__device__ __forceinline__ unsigned f2bf(float f) { const __bf16 b = (__bf16)f; return (unsigned)__builtin_bit_cast(unsigned short, b); }
__device__ __forceinline__ unsigned pk2(float lo, float hi) { return pg8::cvt_pk_bf16(lo, hi); }
__device__ __forceinline__ float bf2f(unsigned short b) { return __builtin_bit_cast(float, ((unsigned)b) << 16); }
__device__ __forceinline__ float bflo(unsigned u) { return __builtin_bit_cast(float, u << 16); }
__device__ __forceinline__ float bfhi(unsigned u) { return __builtin_bit_cast(float, u & 0xffff0000u); }
__device__ __forceinline__ float wave_sum(float v) {
#pragma unroll
    for (int o = 1; o < 64; o <<= 1) v += __shfl_xor(v, o);
    return v;
}
__device__ __forceinline__ float sigmoidf_(float z) { return __builtin_amdgcn_rcpf(1.0f + __expf(-z)); }

struct Args { const float* in[18]; float* out; unsigned char* ws; int ph_lo, ph_hi; };

namespace epi {
using pg8::f32x4; using pg8::u32x4; using pg8::Unit; using pg8::cvt_pk_bf16; using pg8::bf16_t;
enum { X_NONE = 0, X_SIG = 1, X_SILU = 2, X_RELU2 = 3 };
template <int X> __device__ __forceinline__ float xf(float v) {
#ifdef DBG_CONSTGATE
    if (X == X_SIG) return 0.5f + 0.0f * fminf(fmaxf(v, -1.f), 1.f);
#endif
    if (X == X_SIG) return sigmoidf_(v);
    if (X == X_SILU) return v * sigmoidf_(v);
    if (X == X_RELU2) { const float r = fmaxf(v, 0.f); return r * r; }
    return v;
}
template <int X> __device__ __forceinline__ void store_bf16(const f32x4 (&acc)[2][2][4][2], bf16_t* base, int ldc, int row0, int col0, float sc) {
#pragma unroll
    for (int ai = 0; ai < 2; ++ai)
#pragma unroll
        for (int m = 0; m < 4; ++m) { bf16_t* rowp = base + (size_t)(row0 + ai * 128 + m * 16) * ldc + col0;
#pragma unroll
            for (int bj = 0; bj < 2; ++bj) { const f32x4 v0 = acc[ai][bj][m][0], v1 = acc[ai][bj][m][1];
                u32x4 w; w.x = cvt_pk_bf16(xf<X>(v0[0]) * sc, xf<X>(v0[1]) * sc); w.y = cvt_pk_bf16(xf<X>(v0[2]) * sc, xf<X>(v0[3]) * sc);
                w.z = cvt_pk_bf16(xf<X>(v1[0]) * sc, xf<X>(v1[1]) * sc); w.w = cvt_pk_bf16(xf<X>(v1[2]) * sc, xf<X>(v1[3]) * sc);
                *(u32x4*)(rowp + bj * 128) = w; } }
}
__device__ __forceinline__ unsigned pkh2(float a, float b) { h2 t; t.x = (_Float16)a; t.y = (_Float16)b; return __builtin_bit_cast(unsigned, t); }
__device__ __forceinline__ void store_f16(const f32x4 (&acc)[2][2][4][2], unsigned short* base, int ldc, int row0, int col0, float sc) {
#pragma unroll
    for (int ai = 0; ai < 2; ++ai)
#pragma unroll
        for (int m = 0; m < 4; ++m) { unsigned short* rowp = base + (size_t)(row0 + ai * 128 + m * 16) * ldc + col0;
#pragma unroll
            for (int bj = 0; bj < 2; ++bj) { const f32x4 v0 = acc[ai][bj][m][0], v1 = acc[ai][bj][m][1];
                u32x4 w; w.x = pkh2(v0[0] * sc, v0[1] * sc); w.y = pkh2(v0[2] * sc, v0[3] * sc); w.z = pkh2(v1[0] * sc, v1[1] * sc); w.w = pkh2(v1[2] * sc, v1[3] * sc);
                *(u32x4*)(rowp + bj * 128) = w; }
            asm volatile("" ::: "memory"); }
}
template <int NBJ> __device__ __forceinline__ void store_f32(const f32x4 (&acc)[2][2][4][2], float* base, int ldc, int row0, int col0) {
#pragma unroll
    for (int ai = 0; ai < 2; ++ai)
#pragma unroll
        for (int m = 0; m < 4; ++m) { float* rowp = base + (size_t)(row0 + ai * 128 + m * 16) * ldc + col0;
#pragma unroll
            for (int bj = 0; bj < NBJ; ++bj) { *(f32x4*)(rowp + bj * 128) = acc[ai][bj][m][0]; *(f32x4*)(rowp + bj * 128 + 4) = acc[ai][bj][m][1]; } }
}

struct EpiProj {
    static constexpr bool PERM = true, AFTER_DRAIN = false;
    unsigned char* ws;
    __device__ __forceinline__ void operator()(const f32x4 (&acc)[2][2][4][2], const Unit& u, int wr, int wc, int fr, int fq) const {
        const int row0 = u.pm * 256 + wr * 64 + fr, cl = wc * 32 + 8 * fq, pn = u.pn;
        if (pn < 2) store_bf16<X_NONE>(acc, (bf16_t*)(ws + WS_QH), 512, row0, pn * 256 + cl, 1.f);
        else if (pn < 4) {
            float* G = (float*)(ws + WS_G); const float* lb = (const float*)(ws + WS_LB); const int cb = (pn - 2) * 256 + cl;
            f32x4 lbv[2][2];
#pragma unroll
            for (int bj = 0; bj < 2; ++bj)
#pragma unroll
                for (int n = 0; n < 2; ++n) lbv[bj][n] = *(const f32x4*)(lb + cb + bj * 128 + 4 * n);
#pragma unroll
            for (int ai = 0; ai < 2; ++ai)
#pragma unroll
                for (int m = 0; m < 4; ++m) { float* rowp = G + (size_t)(row0 + ai * 128 + m * 16) * 512 + cb;
#pragma unroll
                    for (int bj = 0; bj < 2; ++bj)
#pragma unroll
                        for (int n = 0; n < 2; ++n) { f32x4 o;
#pragma unroll
                            for (int j = 0; j < 4; ++j) { const float l = lbv[bj][n][j]; o[j] = __logf(l + (1.0f - l) * sigmoidf_(acc[ai][bj][m][n][j])); }
                            *(f32x4*)(rowp + bj * 128 + 4 * n) = o; } }
        }
        else if (pn < 6) store_bf16<X_NONE>(acc, (bf16_t*)(ws + WS_VH), 512, row0, (pn - 4) * 256 + cl, 1.f);
        else if (pn < 8) store_bf16<X_SILU>(acc, (bf16_t*)(ws + WS_SG), 512, row0, (pn - 6) * 256 + cl, 1.f);
        else if (pn < 12) store_bf16<X_SIG>(acc, (bf16_t*)(ws + WS_GA), 1024, row0, (pn - 8) * 256 + cl, 1.f);
        else if (pn < 16) store_bf16<X_SIG>(acc, (bf16_t*)(ws + WS_GB), 1024, row0, (pn - 12) * 256 + cl, 1.f);
        else if (pn == 16) store_f32<2>(acc, (float*)(ws + WS_CQ), 256, row0, cl);
        else if (pn == 17) store_bf16<X_NONE>(acc, (bf16_t*)(ws + WS_KV), 256, row0, cl, 1.f);
        else store_f32<1>(acc, (float*)(ws + WS_IKW), 128, row0, cl);
    }
};
struct EpiQI {
    static constexpr bool PERM = true, AFTER_DRAIN = false;
    unsigned char* ws;
    __device__ __forceinline__ void operator()(const f32x4 (&acc)[2][2][4][2], const Unit& u, int wr, int wc, int fr, int fq) const {
        const int row0 = u.pm * 256 + wr * 64 + fr, cl = wc * 32 + 8 * fq, pn = u.pn;
        if (pn < 2) store_bf16<X_NONE>(acc, (bf16_t*)(ws + WS_AQ), 512, row0, pn * 256 + cl, 0.125f);
        else store_f16(acc, (unsigned short*)(ws + WS_IQ), 512, row0, (pn - 2) * 256 + cl, 0.125f);
    }
};
template <int PART> struct EpiMix {
    static constexpr bool PERM = true, AFTER_DRAIN = false;
    unsigned char* ws;
    __device__ __forceinline__ void operator()(const f32x4 (&acc)[2][2][4][2], const Unit& u, int wr, int wc, int fr, int fq) const {
        const int row0 = u.pm * 256 + wr * 64 + fr, col0 = u.pn * 256 + wc * 32 + 8 * fq;
        const bf16_t* gate = (const bf16_t*)(ws + (PART == 0 ? WS_GA : WS_GB));
        const bf16_t* prev = (const bf16_t*)(ws + WS_MIXP); bf16_t* out = (bf16_t*)(ws + (PART == 0 ? WS_MIXP : WS_MIX));
#pragma unroll
        for (int ai = 0; ai < 2; ++ai)
#pragma unroll
            for (int m = 0; m < 4; ++m) { const size_t off = (size_t)(row0 + ai * 128 + m * 16) * 1024 + col0;
#pragma unroll
                for (int bj = 0; bj < 2; ++bj) { u32x4 gv = *(const u32x4*)(gate + off + bj * 128);
#ifdef DBG_NOGATE
                    gv = (u32x4){0x3f803f80u, 0x3f803f80u, 0x3f803f80u, 0x3f803f80u};
#endif
                    u32x4 pv = (u32x4){0u, 0u, 0u, 0u}; if (PART == 1) pv = *(const u32x4*)(prev + off + bj * 128);
                    const f32x4 v0 = acc[ai][bj][m][0], v1 = acc[ai][bj][m][1]; u32x4 w;
                    w.x = cvt_pk_bf16(bflo(pv.x) + bflo(gv.x) * v0[0], bfhi(pv.x) + bfhi(gv.x) * v0[1]);
                    w.y = cvt_pk_bf16(bflo(pv.y) + bflo(gv.y) * v0[2], bfhi(pv.y) + bfhi(gv.y) * v0[3]);
                    w.z = cvt_pk_bf16(bflo(pv.z) + bflo(gv.z) * v1[0], bfhi(pv.z) + bfhi(gv.z) * v1[1]);
                    w.w = cvt_pk_bf16(bflo(pv.w) + bflo(gv.w) * v1[2], bfhi(pv.w) + bfhi(gv.w) * v1[3]);
                    *(u32x4*)(out + off + bj * 128) = w; }
                if (m & 1) asm volatile("" ::: "memory"); }
    }
};
struct EpiResid {
    static constexpr bool PERM = true, AFTER_DRAIN = false;
    const float* base; float* out;
    __device__ __forceinline__ void operator()(const f32x4 (&acc)[2][2][4][2], const Unit& u, int wr, int wc, int fr, int fq) const {
        const int row0 = u.pm * 256 + wr * 64 + fr, col0 = u.pn * 256 + wc * 32 + 8 * fq;
#pragma unroll
        for (int ai = 0; ai < 2; ++ai)
#pragma unroll
            for (int m = 0; m < 4; ++m) { const size_t off = (size_t)(row0 + ai * 128 + m * 16) * 1024 + col0;
#pragma unroll
                for (int bj = 0; bj < 2; ++bj) {
                    const f32x4 b0 = *(const f32x4*)(base + off + bj * 128), b1 = *(const f32x4*)(base + off + bj * 128 + 4);
                    *(f32x4*)(out + off + bj * 128) = b0 + acc[ai][bj][m][0]; *(f32x4*)(out + off + bj * 128 + 4) = b1 + acc[ai][bj][m][1]; }
                if (m & 1) asm volatile("" ::: "memory"); }
    }
};
struct EpiRelu2 {
    static constexpr bool PERM = true, AFTER_DRAIN = false;
    bf16_t* out;
    __device__ __forceinline__ void operator()(const f32x4 (&acc)[2][2][4][2], const Unit& u, int wr, int wc, int fr, int fq) const {
        store_bf16<X_RELU2>(acc, out, DFF, u.pm * 256 + wr * 64 + fr, u.pn * 256 + wc * 32 + 8 * fq, 1.f);
    }
};
}

#define XB_TMO      128
#define XB_XCNT(j)  (256  + 64 * (j))
#define XB_XSUB(j)  (1280 + 64 * (j))
#define XB_XGEN(j)  (2304 + 64 * (j))
#define XB_TOP      3328
#define XB_TOPGEN   3392
#define XCD_BAR_WORDS 3456
#define XB_SPIN_CAP (1u << 18)

__device__ __forceinline__ unsigned xb_ld(unsigned* p)              { return __hip_atomic_load(p, __ATOMIC_RELAXED, __HIP_MEMORY_SCOPE_AGENT); }
__device__ __forceinline__ unsigned xb_add(unsigned* p, unsigned v) { return __hip_atomic_fetch_add(p, v, __ATOMIC_RELAXED, __HIP_MEMORY_SCOPE_AGENT); }
__device__ __forceinline__ unsigned xb_xcc_id() { return (unsigned)__builtin_amdgcn_s_getreg((3 << 11) | 20) & 0xFu; }
#define XB_SPIN(cond, bar) do { unsigned _sp = 0; while (cond) { __builtin_amdgcn_s_sleep(1); \
    if ((++_sp & 255u) == 0u) { if (xb_ld(&(bar)[XB_TMO])) break; if (_sp > XB_SPIN_CAP) { atomicAdd(&(bar)[XB_TMO], 1u); break; } } } } while (0)

struct XcdBarrier {
    unsigned* bar; unsigned x;
    volatile LAS unsigned* st;
};

__device__ __forceinline__ XcdBarrier xcd_barrier_post(unsigned* bar, volatile LAS unsigned* st) {
    XcdBarrier b; b.bar = bar; b.x = xb_xcc_id(); b.st = st;
    if (threadIdx.x == 0) (void)xb_add(&bar[XB_XCNT(b.x)], 1u);
    return b;
}
__device__ __forceinline__ void xcd_barrier_complete(unsigned* bar, unsigned x, unsigned& nloc, unsigned& nx) {
    const unsigned G = gridDim.x * gridDim.y * gridDim.z;
    unsigned sum, cnt, mine, sp = 0u;
    for (;;) {
        sum = 0u; cnt = 0u; mine = 0u;
#pragma unroll
        for (unsigned j = 0; j < 16; ++j) { const unsigned c = xb_ld(&bar[XB_XCNT(j)]); sum += c; cnt += (c > 0u) ? 1u : 0u; mine = (j == x) ? c : mine; }
        if (sum == G) break;
        __builtin_amdgcn_s_sleep(1);
        if ((++sp & 255u) == 0u) { if (xb_ld(&bar[XB_TMO])) break; if (sp > XB_SPIN_CAP) { atomicAdd(&bar[XB_TMO], 1u); break; } }
    }
    nloc = mine > 0u ? mine : 1u; nx = cnt > 0u ? cnt : 1u;
}

__device__ __forceinline__ void xcd_barrier(const XcdBarrier& b) {
    asm volatile("s_waitcnt vmcnt(0)" ::: "memory");
    __syncthreads();
    if (threadIdx.x == 0) {
        unsigned* bar = b.bar;
        __builtin_amdgcn_s_waitcnt(0);
        unsigned nloc = b.st[0], nx = b.st[1];
        if (nloc == 0u) { xcd_barrier_complete(bar, b.x, nloc, nx); b.st[0] = nloc; b.st[1] = nx; }
        const unsigned old = xb_add(&bar[XB_XSUB(b.x)], 1u);
        const unsigned gen = old / nloc;
        if (old + 1u == (gen + 1u) * nloc) {
            __builtin_amdgcn_fence(__ATOMIC_RELEASE, "agent");
            asm volatile("s_waitcnt vmcnt(0)" ::: "memory");
            const unsigned og = xb_add(&bar[XB_TOP], 1u);
            const unsigned tg = og / nx;
            if (og + 1u == (tg + 1u) * nx) xb_add(&bar[XB_TOPGEN], 1u);
            else XB_SPIN(xb_ld(&bar[XB_TOPGEN]) == tg, bar);
            __builtin_amdgcn_fence(__ATOMIC_ACQUIRE, "agent");
            xb_add(&bar[XB_XGEN(b.x)], 1u);
            asm volatile("s_waitcnt vmcnt(0)" ::: "memory");
        } else {
            XB_SPIN(xb_ld(&bar[XB_XGEN(b.x)]) == gen, bar);
            __builtin_amdgcn_fence(__ATOMIC_ACQUIRE, "agent");
            asm volatile("s_waitcnt vmcnt(0)" ::: "memory");
        }
    }
    __syncthreads();
}

struct Ctx {
    LAS unsigned char* lds; int tid, lane, wave, G, bid;
    const float* const* in; float* out; unsigned char* ws;
};

__device__ __forceinline__ int proj_src_col(int j) {
    if (j < 2048) return j;
    if (j < 3072) return 2632 + (j - 2048);
    if (j < 4096) return 3656 + (j - 3072);
    if (j < 4352) return 2048 + (j - 4096);
    if (j < 4608) return 2304 + (j - 4352);
    if (j < 4680) return 2560 + (j - 4608);
    return -1;
}
template <bool MAPPED>
__device__ __forceinline__ void transpose_item(const float* W, int Nsrc, int K, bf16* WT, int row_off, int nblk, LAS float* scr, int item, int lane) {
    const int kb = item / nblk, nb = item % nblk, k0 = 64 * kb, n0 = 32 * nb;
    int sc = n0 + (lane & 31); if (MAPPED) sc = proj_src_col(sc);
#pragma unroll 8
    for (int i = 0; i < 32; ++i) { const int kk = 2 * i + (lane >> 5); scr[kk * 33 + (lane & 31)] = (sc >= 0) ? W[(size_t)(k0 + kk) * Nsrc + sc] : 0.f; }
    LDS_WAIT(); asm volatile("" ::: "memory");
    const int c = lane & 7;
#pragma unroll
    for (int j = 0; j < 4; ++j) { const int n = (lane >> 3) + 8 * j; const LAS float* s = scr + (8 * c) * 33 + n;
        v4u o; o.x = pk2(s[0 * 33], s[1 * 33]); o.y = pk2(s[2 * 33], s[3 * 33]); o.z = pk2(s[4 * 33], s[5 * 33]); o.w = pk2(s[6 * 33], s[7 * 33]);
        *(GAS v4u*)(WT + (size_t)(row_off + n0 + n) * K + k0 + 8 * c) = o; }
    LDS_WAIT(); asm volatile("" ::: "memory");
}
__device__ __forceinline__ void rms_row_to_bf16(const float* xrow, const float* gain, bf16* orow, int lane) {
    const GAS f32x4* xr = (const GAS f32x4*)xrow + lane; const GAS f32x4* gr = (const GAS f32x4*)gain + lane;
    f32x4 v[4]; float s = 0.f;
#pragma unroll
    for (int j = 0; j < 4; ++j) { v[j] = xr[64 * j]; s += (v[j].x * v[j].x + v[j].y * v[j].y) + (v[j].z * v[j].z + v[j].w * v[j].w); }
    const float rstd = 1.0f / sqrtf(wave_sum(s) * (1.f / 1024.f) + EPS);
    GAS unsigned long long* o8 = (GAS unsigned long long*)orow + lane;
#pragma unroll
    for (int j = 0; j < 4; ++j) { const f32x4 g = gr[64 * j];
        o8[64 * j] = (unsigned long long)pk2(v[j].x * rstd * g.x, v[j].y * rstd * g.y) | ((unsigned long long)pk2(v[j].z * rstd * g.z, v[j].w * rstd * g.w) << 32); }
}
__device__ __forceinline__ void p0_prologue(const Ctx& F) {
    LAS float* scr = (LAS float*)(F.lds + F.wave * 16384);
    const int gw = F.bid * NWAVES + F.wave, NGW = F.G * NWAVES;
    bf16* wt_in = (bf16*)(F.ws + WS_WIN); bf16* wt_qi = (bf16*)(F.ws + WS_WQI); bf16* wt_mh = (bf16*)(F.ws + WS_WMH); bf16* wt_ma = (bf16*)(F.ws + WS_WMA);
    bf16* wt_o = (bf16*)(F.ws + WS_WO); bf16* wt_mi = (bf16*)(F.ws + WS_WMI); bf16* wt_mo = (bf16*)(F.ws + WS_WMO);
    constexpr int I_IN = 16 * 152, I_UQ = 4 * 16, I_MH = 8 * 32, I_O = 16 * 32, I_MI = 16 * 128, I_MO = 64 * 32;
    constexpr int NITEMS = I_IN + 2 * I_UQ + 2 * I_MH + I_O + I_MI + I_MO;
    for (int it = gw; it < NITEMS; it += NGW) {
        int r = it;
        if (r < I_IN) { transpose_item<true>(F.in[2], 4680, 1024, wt_in, 0, 152, scr, r, F.lane); continue; } r -= I_IN;
        if (r < I_UQ) { transpose_item<false>(F.in[7], 512, 256, wt_qi, 0, 16, scr, r, F.lane); continue; } r -= I_UQ;
        if (r < I_UQ) { transpose_item<false>(F.in[8], 512, 256, wt_qi, 512, 16, scr, r, F.lane); continue; } r -= I_UQ;
        if (r < I_MH) { transpose_item<false>(F.in[5], 1024, 512, wt_mh, 0, 32, scr, r, F.lane); continue; } r -= I_MH;
        if (r < I_MH) { transpose_item<false>(F.in[12], 1024, 512, wt_ma, 0, 32, scr, r, F.lane); continue; } r -= I_MH;
        if (r < I_O) { transpose_item<false>(F.in[13], 1024, 1024, wt_o, 0, 32, scr, r, F.lane); continue; } r -= I_O;
        if (r < I_MI) { transpose_item<false>(F.in[15], 4096, 1024, wt_mi, 0, 128, scr, r, F.lane); continue; } r -= I_MI;
        transpose_item<false>(F.in[16], 1024, 4096, wt_mo, 0, 32, scr, r, F.lane);
    }
    if (F.bid == 0) {
        float* lb = (float*)(F.ws + WS_LB); const float* lg = F.in[3];
        for (int d = F.tid; d < 512; d += NTHR) lb[d] = 1.0f / (1.0f + expf(lg[512 + d] - lg[d]));
    }
    bf16* H = (bf16*)(F.ws + WS_HM);
    for (int m = gw; m < M; m += NGW) rms_row_to_bf16(F.in[0] + (size_t)m * DM, F.in[1], H + (size_t)m * DM, F.lane);
}

__device__ __forceinline__ void p2_norms(const Ctx& F) {
    const int gw = F.bid * NWAVES + F.wave, NGW = F.G * NWAVES, lane = F.lane;
    const float* CQ = (const float*)(F.ws + WS_CQ); const float* IKW = (const float*)(F.ws + WS_IKW);
    bf16* CQN = (bf16*)(F.ws + WS_CQN); unsigned short* IKN = (unsigned short*)(F.ws + WS_IKN);
    const f32x4 qg = *((const GAS f32x4*)F.in[6] + lane);
    const float kg = F.in[9][lane], kb = F.in[10][lane];
    for (int m = gw; m < M; m += NGW) {
        const f32x4 v = *((const GAS f32x4*)(CQ + (size_t)m * 256) + lane);
        const float ss = wave_sum((v.x * v.x + v.y * v.y) + (v.z * v.z + v.w * v.w));
        const float rstd = 1.0f / sqrtf(ss * (1.f / 256.f) + EPS);
        *((GAS unsigned long long*)(CQN + (size_t)m * 256) + lane) = (unsigned long long)pk2(v.x * rstd * qg.x, v.y * rstd * qg.y) | ((unsigned long long)pk2(v.z * rstd * qg.z, v.w * rstd * qg.w) << 32);
        const float k = IKW[(size_t)m * 128 + lane];
        const float mu = wave_sum(k) * (1.f / 64.f); const float dk = k - mu;
        const float var = wave_sum(dk * dk) * (1.f / 64.f);
        const float y = dk * (1.0f / sqrtf(var + EPS)) * kg + kb;
        const _Float16 yh = (_Float16)y;
        IKN[(size_t)m * 64 + lane] = __builtin_bit_cast(unsigned short, yh);
    }
}
__device__ __forceinline__ void p8_hm(const Ctx& F) {
    const int gw = F.bid * NWAVES + F.wave, NGW = F.G * NWAVES;
    bf16* HMb = (bf16*)(F.ws + WS_HM);
    for (int m = gw; m < M; m += NGW) rms_row_to_bf16(F.out + (size_t)m * DM, F.in[14], HMb + (size_t)m * DM, F.lane);
}
__device__ __forceinline__ void p11_final(const Ctx& F) {
    const int gw = F.bid * NWAVES + F.wave, NGW = F.G * NWAVES, lane = F.lane;
    const GAS f32x4* gr = (const GAS f32x4*)F.in[17] + lane;
    for (int m = gw; m < M; m += NGW) {
        GAS f32x4* xr = (GAS f32x4*)(F.out + (size_t)m * DM) + lane;
        f32x4 v[4]; float s = 0.f;
#pragma unroll
        for (int j = 0; j < 4; ++j) { v[j] = xr[64 * j]; s += (v[j].x * v[j].x + v[j].y * v[j].y) + (v[j].z * v[j].z + v[j].w * v[j].w); }
        const float rstd = 1.0f / sqrtf(wave_sum(s) * (1.f / 1024.f) + EPS);
#pragma unroll
        for (int j = 0; j < 4; ++j) xr[64 * j] = v[j] * rstd * gr[64 * j];
    }
}

namespace hg {
constexpr int RS1 = 272, RS2 = 144;
constexpr int O_QA = 0, O_KA = O_QA + 64 * RS1, O_KST = O_KA + 64 * RS1, O_VT = O_KST + 128 * RS2, O_SPT = O_VT + 128 * RS2;
constexpr int O_EBM = O_SPT + 128 * RS1, O_ELA = O_EBM + 512, O_TOT = O_ELA + 512, O_RED = O_TOT + 2048, O_END = O_RED + 512;
static_assert(O_END <= 120000, "hgrn lds");
}
__device__ __forceinline__ bf16x8 lds_b128(const LAS unsigned char* p) { return *(const LAS bf16x8*)p; }
__device__ __forceinline__ void hgrn_sequence(const Ctx& F, int bh) {
    using namespace hg;
    const int b = bh >> 2, h = bh & 3, tid = F.tid, lane = F.lane, w = F.wave, g = lane >> 4, c16 = lane & 15, tt = w & 3, eh = w >> 2;
    LAS unsigned char* L = F.lds;
    LAS float* eBm = (LAS float*)(L + O_EBM); LAS float* eLa = (LAS float*)(L + O_ELA); LAS float* tot = (LAS float*)(L + O_TOT); LAS float* red = (LAS float*)(L + O_RED);
    const float* Gp = (const float*)(F.ws + WS_G); const bf16* Qp = (const bf16*)(F.ws + WS_QH); const bf16* Vp = (const bf16*)(F.ws + WS_VH);
    const bf16* SGp = (const bf16*)(F.ws + WS_SG); bf16* OAp = (bf16*)(F.ws + WS_OA); const float* hgn = F.in[4];
    f32x4 S[8];
#pragma unroll
    for (int i = 0; i < 8; ++i) S[i] = (f32x4){0.f, 0.f, 0.f, 0.f};
    const int d = tid & 127, qr = tid >> 7;
    for (int c = 0; c < SEQ / 64; ++c) {
        const size_t R0 = (size_t)b * SEQ + (size_t)c * 64;
        float gv[16], cs[16];
        {
            const size_t base = (R0 + 16 * qr) * 512 + h * 128 + d;
            float run = 0.f;
#pragma unroll
            for (int i = 0; i < 16; ++i) { gv[i] = Gp[base + (size_t)i * 512]; run += gv[i]; cs[i] = run; }
            tot[qr * 128 + d] = run;
            unsigned vp[8];
#pragma unroll
            for (int i = 0; i < 8; ++i) vp[i] = (unsigned)Vp[base + (size_t)(2 * i) * 512] | ((unsigned)Vp[base + (size_t)(2 * i + 1) * 512] << 16);
            *(LAS v4u*)(L + O_VT + d * RS2 + qr * 32) = (v4u){vp[0], vp[1], vp[2], vp[3]};
            *(LAS v4u*)(L + O_VT + d * RS2 + qr * 32 + 16) = (v4u){vp[4], vp[5], vp[6], vp[7]};
        }
        __syncthreads();
        {
            const size_t base = (R0 + 16 * qr) * 512 + h * 128 + d;
            const float t0 = tot[d], t1 = tot[128 + d], t2 = tot[256 + d], t3 = tot[384 + d];
            const float off = (qr > 0 ? t0 : 0.f) + (qr > 1 ? t1 : 0.f) + (qr > 2 ? t2 : 0.f);
            const float Bmid = t0 + t1, blast = Bmid + t2 + t3;
            unsigned ksp[8]; float kprev = 0.f;
#pragma unroll
            for (int i = 0; i < 16; ++i) {
                const float bi = off + cs[i], q = bf2f(Qp[base + (size_t)i * 512]);
                const float k = 1.0f - __expf(gv[i]);
                const float qa = q * __expf(fminf(bi - Bmid, 80.f)), ka = k * __expf(fminf(Bmid - bi, 80.f)), ks = k * __expf(blast - bi);
                *(LAS unsigned short*)(L + O_QA + (16 * qr + i) * RS1 + d * 2) = (unsigned short)f2bf(qa);
                *(LAS unsigned short*)(L + O_KA + (16 * qr + i) * RS1 + d * 2) = (unsigned short)f2bf(ka);
                if (i & 1) ksp[i >> 1] = pk2(kprev, ks); else kprev = ks;
            }
            *(LAS v4u*)(L + O_KST + d * RS2 + qr * 32) = (v4u){ksp[0], ksp[1], ksp[2], ksp[3]};
            *(LAS v4u*)(L + O_KST + d * RS2 + qr * 32 + 16) = (v4u){ksp[4], ksp[5], ksp[6], ksp[7]};
            if (qr == 0) { eBm[d] = __expf(Bmid); eLa[d] = __expf(blast); }
        }
        __syncthreads();
        {
            const f32x4 eb = *(const LAS f32x4*)(eBm + 16 * w + 4 * g);
#pragma unroll
            for (int et = 0; et < 8; ++et) { const f32x4 v = S[et] * eb;
                *(LAS v2u*)(L + O_SPT + (16 * et + c16) * RS1 + (16 * w + 4 * g) * 2) = (v2u){pk2(v[0], v[1]), pk2(v[2], v[3])}; }
        }
        __syncthreads();
        bf16x8 qf[4];
#pragma unroll
        for (int ks = 0; ks < 4; ++ks) qf[ks] = lds_b128(L + O_QA + (16 * tt + c16) * RS1 + (32 * ks + 8 * g) * 2);
        f32x4 x[4];
#pragma unroll
        for (int st = 0; st < 4; ++st) {
            x[st] = (f32x4){0.f, 0.f, 0.f, 0.f};
            if (st <= tt) {
#pragma unroll
                for (int ks = 0; ks < 4; ++ks) x[st] = __builtin_amdgcn_mfma_f32_16x16x32_bf16(lds_b128(L + O_KA + (16 * st + c16) * RS1 + (32 * ks + 8 * g) * 2), qf[ks], x[st], 0, 0, 0);
                if (st == tt) {
#pragma unroll
                    for (int i = 0; i < 4; ++i) if (4 * g + i > c16) x[st][i] = 0.f;
                }
            }
        }
        bf16x8 xb[2];
#pragma unroll
        for (int p = 0; p < 2; ++p) { const v4u t = (v4u){pk2(x[2 * p][0], x[2 * p][1]), pk2(x[2 * p][2], x[2 * p][3]), pk2(x[2 * p + 1][0], x[2 * p + 1][1]), pk2(x[2 * p + 1][2], x[2 * p + 1][3])};
            xb[p] = __builtin_bit_cast(bf16x8, t); }
        f32x4 oT[4];
#pragma unroll
        for (int e4 = 0; e4 < 4; ++e4) {
            const int et = 4 * eh + e4; f32x4 acc = (f32x4){0.f, 0.f, 0.f, 0.f};
#pragma unroll
            for (int p = 0; p < 2; ++p) {
                if (p == 0 || tt >= 2) {
                    const v2u a0 = *(const LAS v2u*)(L + O_VT + (16 * et + c16) * RS2 + (32 * p + 4 * g) * 2);
                    const v2u a1 = *(const LAS v2u*)(L + O_VT + (16 * et + c16) * RS2 + (32 * p + 16 + 4 * g) * 2);
                    const v4u a = (v4u){a0.x, a0.y, a1.x, a1.y};
                    acc = __builtin_amdgcn_mfma_f32_16x16x32_bf16(__builtin_bit_cast(bf16x8, a), xb[p], acc, 0, 0, 0);
                }
            }
#pragma unroll
            for (int ks = 0; ks < 4; ++ks) acc = __builtin_amdgcn_mfma_f32_16x16x32_bf16(lds_b128(L + O_SPT + (16 * et + c16) * RS1 + (32 * ks + 8 * g) * 2), qf[ks], acc, 0, 0, 0);
            oT[e4] = acc;
        }
        {
            const f32x4 el = *(const LAS f32x4*)(eLa + 16 * w + 4 * g);
#pragma unroll
            for (int et = 0; et < 8; ++et) S[et] = S[et] * el;
#pragma unroll
            for (int ks = 0; ks < 2; ++ks) { const bf16x8 a = lds_b128(L + O_KST + (16 * w + c16) * RS2 + (32 * ks + 8 * g) * 2);
#pragma unroll
                for (int et = 0; et < 8; ++et) S[et] = __builtin_amdgcn_mfma_f32_16x16x32_bf16(a, lds_b128(L + O_VT + (16 * et + c16) * RS2 + (32 * ks + 8 * g) * 2), S[et], 0, 0, 0); }
        }
        float ss = 0.f;
#pragma unroll
        for (int e4 = 0; e4 < 4; ++e4) ss += (oT[e4][0] * oT[e4][0] + oT[e4][1] * oT[e4][1]) + (oT[e4][2] * oT[e4][2] + oT[e4][3] * oT[e4][3]);
        ss += __shfl_xor(ss, 16); ss += __shfl_xor(ss, 32);
        if (g == 0) red[(16 * tt + c16) * 2 + eh] = ss;
        __syncthreads();
        {
            const float rstd = 1.0f / sqrtf((red[(16 * tt + c16) * 2] + red[(16 * tt + c16) * 2 + 1]) * (1.f / 128.f) + EPS);
            const size_t rowoff = (R0 + 16 * tt + c16) * 512 + h * 128;
#pragma unroll
            for (int e4 = 0; e4 < 4; ++e4) { const int e0 = 16 * (4 * eh + e4) + 4 * g;
                const f32x4 gn = *(const f32x4*)(hgn + h * 128 + e0); const v2u sg = *(const v2u*)(SGp + rowoff + e0);
                const f32x4 o = oT[e4] * rstd * gn;
                *(v2u*)(OAp + rowoff + e0) = (v2u){pk2(o[0] * bflo(sg.x), o[1] * bfhi(sg.x)), pk2(o[2] * bflo(sg.y), o[3] * bfhi(sg.y))}; }
        }
    }
    __syncthreads();
}

namespace ds {
constexpr int O_KEYS = 0, O_HIST = 32768, O_MISC = 33792, O_Q = 34816, O_LG = 36864, O_SEL = 45056, O_BKT = 46080, O_RB = 46592, O_END = 47616;
}
__device__ __forceinline__ unsigned pack_key(float v, int s) {
    unsigned u = __builtin_bit_cast(unsigned, v); u = (u == 0x80000000u) ? 0u : u;
    const unsigned m = (u >> 31) ? 0xFFFFFFFFu : 0x80000000u;
    return ((u ^ m) & 0xFFFFE000u) | (unsigned)(8191 - s);
}
__device__ __forceinline__ void block_select256(LAS unsigned* keys, int n, LAS unsigned* hist, LAS unsigned* misc, int tid, int lane, int wave) {
    unsigned prefix = 0u, need = 256u;
#pragma unroll 1
    for (int r = 0; r < 4; ++r) {
        const int shift = 24 - 8 * r;
        if (tid < 256) hist[tid] = 0u;
        __syncthreads();
        for (int i = tid; i < n; i += NTHR) { const unsigned k = keys[i];
            if (r == 0 || (k >> (shift + 8)) == (prefix >> (shift + 8))) __hip_atomic_fetch_add(hist + ((k >> shift) & 255u), 1u, __ATOMIC_RELAXED, __HIP_MEMORY_SCOPE_WORKGROUP); }
        __syncthreads();
        if (wave == 0) {
            const int b0 = 4 * (63 - lane);
            const v4u h4 = *(const LAS v4u*)(hist + b0);
            const unsigned s = h4.x + h4.y + h4.z + h4.w;
            unsigned incl = s;
#pragma unroll
            for (int o = 1; o < 64; o <<= 1) { const unsigned t = __shfl_up(incl, o); if (lane >= o) incl += t; }
            const unsigned excl = incl - s;
            if (incl >= need && excl < need) {
                unsigned c = excl; int bin = b0 + 3;
                if (c + h4.w >= need) bin = b0 + 3; else { c += h4.w; if (c + h4.z >= need) bin = b0 + 2; else { c += h4.z; if (c + h4.y >= need) bin = b0 + 1; else { c += h4.y; bin = b0; } } }
                misc[0] = prefix | ((unsigned)bin << shift); misc[1] = need - c;
            }
        }
        __syncthreads();
        prefix = misc[0]; need = misc[1];
        __syncthreads();
    }
}
__device__ __forceinline__ void dsa_tables(const Ctx& F) {
    LAS int* bkt = (LAS int*)(F.lds + ds::O_BKT); LAS float* rb = (LAS float*)(F.lds + ds::O_RB);
    if (F.tid < 128) { const int dd = F.tid; int bk = dd;
        if (dd >= 16) { const int lg = 16 + (int)(logf((float)dd / 16.0f) / 2.0794415416798357f * 16.0f); bk = lg < 31 ? lg : 31; }
        bkt[dd] = bk; }
    if (F.tid < 256) rb[F.tid] = F.in[11][F.tid];
    __syncthreads();
}
__device__ __forceinline__ void dsa_row(const Ctx& F, int b, int t) {
    using namespace ds;
    const int tid = F.tid, lane = F.lane, wave = F.wave;
    LAS unsigned char* L = F.lds;
    LAS unsigned* keys = (LAS unsigned*)(L + O_KEYS); LAS unsigned* hist = (LAS unsigned*)(L + O_HIST); LAS unsigned* misc = (LAS unsigned*)(L + O_MISC);
    LAS float* qs = (LAS float*)(L + O_Q); LAS float* lg = (LAS float*)(L + O_LG); LAS int* sel = (LAS int*)(L + O_SEL);
    LAS int* bkt = (LAS int*)(L + O_BKT); LAS float* rb = (LAS float*)(L + O_RB);
    const size_t row = (size_t)b * SEQ + t; const int n = t + 1;
    const unsigned short* IQ = (const unsigned short*)(F.ws + WS_IQ); const unsigned short* IKN = (const unsigned short*)(F.ws + WS_IKN);
    const float* IKW = (const float*)(F.ws + WS_IKW); const bf16* AQ = (const bf16*)(F.ws + WS_AQ); const bf16* KV = (const bf16*)(F.ws + WS_KV);
    bf16* OB = (bf16*)(F.ws + WS_OB);
    {
        const int head = tid & 7;
        h8 qh[8];
#pragma unroll
        for (int j = 0; j < 8; ++j) qh[j] = *(const h8*)(IQ + row * 512 + head * 64 + 8 * j);
        const float wh = IKW[row * 128 + 64 + head] * 0.35355339059327373f;
        for (int s0 = 0; s0 < n; s0 += 64) {
            const int s = s0 + (tid >> 3); float v = 0.f;
            if (s < n) {
                const unsigned short* kp = IKN + ((size_t)b * SEQ + s) * 64; float dot = 0.f;
#pragma unroll
                for (int j = 0; j < 8; ++j) { const h8 kk = *(const h8*)(kp + 8 * j);
                    dot = __builtin_amdgcn_fdot2((h2){qh[j][0], qh[j][1]}, (h2){kk[0], kk[1]}, dot, false);
                    dot = __builtin_amdgcn_fdot2((h2){qh[j][2], qh[j][3]}, (h2){kk[2], kk[3]}, dot, false);
                    dot = __builtin_amdgcn_fdot2((h2){qh[j][4], qh[j][5]}, (h2){kk[4], kk[5]}, dot, false);
                    dot = __builtin_amdgcn_fdot2((h2){qh[j][6], qh[j][7]}, (h2){kk[6], kk[7]}, dot, false); }
                v = wh * fmaxf(dot, 0.f);
            }
            v += __shfl_xor(v, 1); v += __shfl_xor(v, 2); v += __shfl_xor(v, 4);
            if (head == 0 && s < n) keys[s] = pack_key(v, s);
        }
    }
    __syncthreads();
    unsigned thr = 0u;
    if (n > 256) { block_select256(keys, n, hist, misc, tid, lane, wave); thr = misc[0]; }
    __syncthreads();
    {
        int cnt = 0;
#pragma unroll 1
        for (int i = 0; i < 16; ++i) { const int idx = wave * 1024 + i * 64 + lane; const bool keep = idx < n && keys[idx] >= thr;
            cnt += __builtin_popcountll(__ballot(keep)); }
        if (lane == 0) misc[8 + wave] = (unsigned)cnt;
        __syncthreads();
        int off = 0;
        for (int ww = 0; ww < wave; ++ww) off += (int)misc[8 + ww];
#pragma unroll 1
        for (int i = 0; i < 16; ++i) { const int idx = wave * 1024 + i * 64 + lane; const unsigned k = idx < n ? keys[idx] : 0u; const bool keep = idx < n && k >= thr;
            const unsigned long long bal = __ballot(keep);
            if (keep) sel[off + __builtin_popcountll(bal & ((1ull << lane) - 1ull))] = 8191 - (int)(k & 8191u);
            off += __builtin_popcountll(bal); }
    }
    const int nsel = n < 256 ? n : 256;
    { const int hd = tid >> 6, dd = tid & 63; qs[((hd >> 2) * 64 + dd) * 4 + (hd & 3)] = bf2f(AQ[row * 512 + tid]); }
    __syncthreads();
    {
        const int j = tid & 255, grp = tid >> 8;
        if (j < nsel) {
            const int sidx = sel[j]; const bf16* kp = KV + ((size_t)b * SEQ + sidx) * 256 + grp * 64;
            f32x4 a = (f32x4){0.f, 0.f, 0.f, 0.f};
#pragma unroll 1
            for (int c = 0; c < 8; ++c) { const v4u kk = *(const v4u*)(kp + 8 * c);
                const float kf[8] = {bflo(kk.x), bfhi(kk.x), bflo(kk.y), bfhi(kk.y), bflo(kk.z), bfhi(kk.z), bflo(kk.w), bfhi(kk.w)};
#pragma unroll
                for (int e = 0; e < 8; ++e) a += *(const LAS f32x4*)(qs + (grp * 64 + 8 * c + e) * 4) * kf[e]; }
            const float a0 = a[0], a1 = a[1], a2 = a[2], a3 = a[3];
            const int dist = t - sidx; const int bk = dist < 128 ? bkt[dist] : 31;
            lg[(grp * 4 + 0) * 256 + j] = a0 + rb[bk * 8 + grp * 4 + 0]; lg[(grp * 4 + 1) * 256 + j] = a1 + rb[bk * 8 + grp * 4 + 1];
            lg[(grp * 4 + 2) * 256 + j] = a2 + rb[bk * 8 + grp * 4 + 2]; lg[(grp * 4 + 3) * 256 + j] = a3 + rb[bk * 8 + grp * 4 + 3];
        }
    }
    __syncthreads();
    {
        float v[4]; float mx = -3.0e38f;
#pragma unroll
        for (int i = 0; i < 4; ++i) { const int j = lane + 64 * i; v[i] = j < nsel ? lg[wave * 256 + j] : -3.0e38f; mx = fmaxf(mx, v[i]); }
#pragma unroll
        for (int o = 1; o < 64; o <<= 1) mx = fmaxf(mx, __shfl_xor(mx, o));
        float sm = 0.f;
#pragma unroll
        for (int i = 0; i < 4; ++i) { const int j = lane + 64 * i; v[i] = j < nsel ? __expf(v[i] - mx) : 0.f; sm += v[i]; }
        sm = wave_sum(sm); const float inv = 1.0f / sm;
#pragma unroll
        for (int i = 0; i < 4; ++i) { const int j = lane + 64 * i; lg[wave * 256 + j] = v[i] * inv; }
    }
    __syncthreads();
    {
        const int e = tid & 127, grp = e >> 6, r = tid >> 7, head = grp * 4 + r; float acc = 0.f;
        const bf16* vp = KV + (size_t)b * SEQ * 256 + 128 + e;
        for (int j = 0; j < nsel; ++j) acc += lg[head * 256 + j] * bf2f(vp[(size_t)sel[j] * 256]);
        OB[row * 512 + head * 64 + (e & 63)] = (bf16)f2bf(acc);
    }
    __syncthreads();
}
__device__ __forceinline__ void fill_zero_bf16(const Ctx& F, bf16* p, size_t nelem) {
    v4u* q = (v4u*)p; const size_t n16 = nelem / 8;
    for (size_t i = (size_t)F.bid * NTHR + F.tid; i < n16; i += (size_t)F.G * NTHR) q[i] = (v4u){0u, 0u, 0u, 0u};
}
__device__ __forceinline__ void p4_mixers(const Ctx& F) {
    LAS unsigned* misc = (LAS unsigned*)(F.lds + MISC_OFF);
#if DBG_SKIP_HGRN == 2
    { v4u* q = (v4u*)(F.ws + WS_OA); const size_t n16 = (size_t)M * 512 / 8;
      for (size_t i = (size_t)F.bid * NTHR + F.tid; i < n16; i += (size_t)F.G * NTHR) q[i] = (v4u){0x3c233c23u, 0x3c233c23u, 0x3c233c23u, 0x3c233c23u}; }
#elif DBG_SKIP_HGRN
    fill_zero_bf16(F, (bf16*)(F.ws + WS_OA), (size_t)M * 512);
#else
    if (F.bid < 16) hgrn_sequence(F, F.bid);
#endif
#if DBG_SKIP_DSA
    fill_zero_bf16(F, (bf16*)(F.ws + WS_OB), (size_t)M * 512);
#else
    dsa_tables(F);
    gu32* head = (gu32*)(F.ws + WS_CTL) + CW_Q;
    for (;;) {
        if (F.tid == 0) misc[4] = __hip_atomic_fetch_add(head, 1u, __ATOMIC_RELAXED, __HIP_MEMORY_SCOPE_AGENT);
        __syncthreads();
        const unsigned u = misc[4];
        __syncthreads();
        if (u >= (unsigned)M) break;
        dsa_row(F, (int)(u & 3u), 8191 - (int)(u >> 2));
    }
#endif
}

__global__ void __launch_bounds__(NTHR, 2) mk_fwd(Args args) {
    extern __shared__ __attribute__((aligned(16))) unsigned char lds_raw[];
    Ctx F;
    F.lds = (LAS unsigned char*)lds_raw; F.tid = threadIdx.x; F.lane = F.tid & 63; F.wave = __builtin_amdgcn_readfirstlane(F.tid >> 6);
    F.G = gridDim.x; F.bid = blockIdx.x; F.in = args.in; F.out = args.out; F.ws = args.ws;
    volatile LAS unsigned* MISC = (volatile LAS unsigned*)(F.lds + MISC_OFF);
    if (F.tid < 64) MISC[F.tid] = 0u;
    __syncthreads();
    const int lo = args.ph_lo, hi = args.ph_hi;
    unsigned* barw = (unsigned*)(F.ws + WS_CTL) + CW_BAR + (MK_N_LAUNCHES == 1 ? 0 : 0);
    XcdBarrier bar; bar.bar = barw; bar.x = 0; bar.st = nullptr;
    if (hi - lo > 1) bar = xcd_barrier_post(barw, MISC);
#define IN(k) (lo <= (k) && (k) < hi)
#ifdef ONLYP
#define PH_ON(k) ((k) == ONLYP)
#else
#define PH_ON(k) true
#endif
#define SEAM(k) do { if (IN(k) && IN((k) + 1)) xcd_barrier(bar); } while (0)

    if (PH_ON(0) && IN(0)) { p0_prologue(F); } SEAM(0);
    if (PH_ON(1) && IN(1)) {
        pg8::Gemm g{(const pg8::bf16_t*)(F.ws + WS_HM), (const pg8::bf16_t*)(F.ws + WS_WIN), M, NPROJ, DM}; pg8::StaticOrder S; S.init(M, NPROJ, F.G, F.bid);
        epi::EpiProj E{F.ws};
        pg8::gemm_phase<epi::EpiProj, pg8::StaticOrder, true, true>(F.lds, g, S, E);
    } SEAM(1);
    if (PH_ON(2) && IN(2)) { p2_norms(F); } SEAM(2);
    if (PH_ON(3) && IN(3)) {
        pg8::Gemm g{(const pg8::bf16_t*)(F.ws + WS_CQN), (const pg8::bf16_t*)(F.ws + WS_WQI), M, 1024, 256}; pg8::StaticOrder S; S.init(M, 1024, F.G, F.bid);
        epi::EpiQI E{F.ws};
        pg8::gemm_phase<epi::EpiQI, pg8::StaticOrder, true, true>(F.lds, g, S, E);
    } SEAM(3);
    if (PH_ON(4) && IN(4)) { p4_mixers(F); } SEAM(4);
    if (PH_ON(5) && IN(5)) {
        pg8::Gemm g{(const pg8::bf16_t*)(F.ws + WS_OA), (const pg8::bf16_t*)(F.ws + WS_WMH), M, 1024, 512}; pg8::StaticOrder S; S.init(M, 1024, F.G, F.bid);
        epi::EpiMix<0> E{F.ws};
        pg8::gemm_phase<epi::EpiMix<0>, pg8::StaticOrder, true, true>(F.lds, g, S, E);
    } SEAM(5);
    if (PH_ON(6) && IN(6)) {
        pg8::Gemm g{(const pg8::bf16_t*)(F.ws + WS_OB), (const pg8::bf16_t*)(F.ws + WS_WMA), M, 1024, 512}; pg8::StaticOrder S; S.init(M, 1024, F.G, F.bid);
        epi::EpiMix<1> E{F.ws};
        pg8::gemm_phase<epi::EpiMix<1>, pg8::StaticOrder, true, true>(F.lds, g, S, E);
    } SEAM(6);
    if (PH_ON(7) && IN(7)) {
        pg8::Gemm g{(const pg8::bf16_t*)(F.ws + WS_MIX), (const pg8::bf16_t*)(F.ws + WS_WO), M, 1024, 1024}; pg8::StaticOrder S; S.init(M, 1024, F.G, F.bid);
        epi::EpiResid E{F.in[0], F.out};
        pg8::gemm_phase<epi::EpiResid, pg8::StaticOrder, true, true>(F.lds, g, S, E);
    } SEAM(7);
    if (PH_ON(8) && IN(8)) { p8_hm(F); } SEAM(8);
    if (PH_ON(9) && IN(9)) {
        pg8::Gemm g{(const pg8::bf16_t*)(F.ws + WS_HM), (const pg8::bf16_t*)(F.ws + WS_WMI), M, DFF, 1024}; pg8::StaticOrder S; S.init(M, DFF, F.G, F.bid);
        epi::EpiRelu2 E{(pg8::bf16_t*)(F.ws + WS_HID)};
        pg8::gemm_phase<epi::EpiRelu2, pg8::StaticOrder, true, true>(F.lds, g, S, E);
    } SEAM(9);
    if (PH_ON(10) && IN(10)) {
        pg8::Gemm g{(const pg8::bf16_t*)(F.ws + WS_HID), (const pg8::bf16_t*)(F.ws + WS_WMO), M, 1024, DFF}; pg8::StaticOrder S; S.init(M, 1024, F.G, F.bid);
        epi::EpiResid E{F.out, F.out};
        pg8::gemm_phase<epi::EpiResid, pg8::StaticOrder, true, true>(F.lds, g, S, E);
    } SEAM(10);
    if (PH_ON(11) && IN(11)) { p11_final(F); }
#undef IN
#undef SEAM
}

extern "C" void kernel_launch(void* const* d_in, const int* in_sizes, int n_in, void* d_out, int out_size, void* d_ws, size_t ws_size, hipStream_t stream) {
    static int grid = 0;
    if (grid == 0) {
        if (n_in != 18 || in_sizes[0] != M * DM || out_size != M * DM || ws_size < WS_END) {
            fprintf(stderr, "kernel_launch: unexpected shapes (n_in %d, in0 %d, out %d, ws %zu); nothing launched\n", n_in, n_in > 0 ? in_sizes[0] : -1, out_size, ws_size); grid = -1; return; }
        int dev = 0, cus = 0, per_cu = 0;
        if (hipGetDevice(&dev) != hipSuccess || hipDeviceGetAttribute(&cus, hipDeviceAttributeMultiprocessorCount, dev) != hipSuccess) { grid = -1; return; }
        if (hipFuncSetAttribute((const void*)mk_fwd, hipFuncAttributeMaxDynamicSharedMemorySize, LDS_BYTES) != hipSuccess) { fprintf(stderr, "kernel_launch: hipFuncSetAttribute failed\n"); grid = -1; return; }
        if (hipOccupancyMaxActiveBlocksPerMultiprocessor(&per_cu, (const void*)mk_fwd, NTHR, LDS_BYTES) != hipSuccess || per_cu < 1) {
            fprintf(stderr, "kernel_launch: occupancy query reports %d workgroups per CU\n", per_cu); }
        (void)hipGetLastError();
        grid = cus;
    }
    if (grid < 0) return;
    if (hipMemsetAsync((char*)d_ws + WS_CTL, 0, CTL_ZERO_BYTES, stream) != hipSuccess) return;
    Args a{};
    for (int i = 0; i < 18; ++i) a.in[i] = (const float*)d_in[i];
    a.out = (float*)d_out; a.ws = (unsigned char*)d_ws;
#if MK_N_LAUNCHES == 1
    a.ph_lo = 0; a.ph_hi = NPHASE;
    hipLaunchKernelGGL(mk_fwd, dim3(grid), dim3(NTHR), LDS_BYTES, stream, a);
#else
    for (int p = 0; p < NPHASE; ++p) { a.ph_lo = p; a.ph_hi = p + 1; hipLaunchKernelGGL(mk_fwd, dim3(grid), dim3(NTHR), LDS_BYTES, stream, a); }
#endif
}
```

```cpp
#include <hip/hip_runtime.h>
#include <cstdio>
#include <cstdint>
#include <type_traits>
namespace pg8 {
#define PG8_LAS __attribute__((address_space(3)))
typedef unsigned short bf16_t;
typedef short bf16x8 __attribute__((ext_vector_type(8)));
typedef float f32x4 __attribute__((ext_vector_type(4)));
typedef unsigned u32x4 __attribute__((ext_vector_type(4)));
constexpr int BM = 256, BK = 64, HALF = 128, HTB = HALF * BK * 2  , STAGE_BYTES = 8 * HTB, NXCD = 8, WGM = 8;

__host__ __device__ __forceinline__ int lds_byte(int r, int c) { const int st = (r >> 4) * 2 + (c >> 5), rr = r & 15, cc = c & 31, ob = rr * 64 + cc * 2; return st * 1024 + (ob ^ (((ob >> 9) & 1) << 5)); }
__host__ __device__ __forceinline__ void stage_rc(int b, int& R, int& C) { const int st = b / 1024, sb = b % 1024, swz = sb ^ (((sb >> 9) & 1) << 5); R = (st >> 1) * 16 + swz / 64; C = (st & 1) * 32 + (swz % 64) / 2; }
__host__ __device__ __forceinline__ int perm32(int rho) { const int n = rho >> 4, i = rho & 15; return 8 * (i >> 2) + 4 * n + (i & 3); }

struct Unit { int pm, pn; };
struct Gemm { const bf16_t* A; const bf16_t* Bt; int M, N, K; };

struct StaticOrder {
    int nM, nN, nwg, G, c;
    __host__ __device__ void init(int M, int N, int G_, int c_) { nM = M / BM; nN = N / BM; nwg = nM * nN; G = G_; c = c_; }
    __host__ __device__ bool next(int i, Unit& u) const {
        const long L = (long)i * G + c; if (L >= nwg) return false;
        int wgid = (int)L; { const int q = nwg / NXCD, r = nwg % NXCD, xcd = wgid % NXCD, off = wgid / NXCD; wgid = (xcd < r ? xcd * (q + 1) : r * (q + 1) + (xcd - r) * q) + off; }
        const int nig = WGM * nN, gid = wgid / nig, fm = gid * WGM, gsz = (nM - fm) < WGM ? (nM - fm) : WGM;
        u.pm = fm + ((wgid % nig) % gsz); u.pn = (wgid % nig) / gsz; return true;
    }
    __device__ __forceinline__ void a_ready(const Unit&) const {}
    __device__ __forceinline__ void done(const Unit&) const {}
};
typedef __bf16 bf16x2_t __attribute__((ext_vector_type(2)));
typedef float f32x2_t __attribute__((ext_vector_type(2)));
__device__ __forceinline__ unsigned cvt_pk_bf16(float lo, float hi) { const f32x2_t v = {lo, hi}; const bf16x2_t b = __builtin_convertvector(v, bf16x2_t); return __builtin_bit_cast(unsigned, b); }
typedef float f32x2 __attribute__((ext_vector_type(2)));
template <class Epi, class Sched, bool ALIGN_EPI = false, bool SP2 = false>
__device__ __forceinline__ void gemm_phase(PG8_LAS unsigned char* lds, const Gemm g, const Sched& S, const Epi& E, const int wid  ) {
    int lane_; asm volatile("v_mbcnt_lo_u32_b32 %0, -1, 0\n\tv_mbcnt_hi_u32_b32 %0, -1, %0" : "=v"(lane_));
    const int lane = lane_, tid = wid * 64 + lane, wr = wid >> 2, wc = wid & 3, fr = lane & 15, fq = lane >> 4;
    const int K = g.K, nt = K / BK;
    unsigned voffA[2], voffB[2];
#pragma unroll
    for (int i = 0; i < 2; ++i) { int R, C; stage_rc(tid * 16 + i * 8192, R, C); const int Rb = Epi::PERM ? ((R & ~31) + perm32(R & 31)) : R;
        voffA[i] = (unsigned)(R * K + C) * 2u; voffB[i] = (unsigned)(Rb * K + C) * 2u; }
    const size_t kstep = (size_t)(BK * 2);
    const size_t hstep = (size_t)HALF * K * 2;
    const size_t tstep = 2 * hstep;
    const unsigned ldsw = (unsigned)wid * 1024u;
    const int aoff = lds_byte(wr * 64 + fr, fq * 8), boff = lds_byte(wc * 32 + fr, fq * 8);
#define PG8_SA(b, h) (((b) * 2 + (h)) * HTB)
#define PG8_SB(b, h) ((4 + (b) * 2 + (h)) * HTB)
#define PG8_STAGE(bufoff, gbase, voff) do { _Pragma("unroll") for (int _i = 0; _i < 2; ++_i) \
        __builtin_amdgcn_global_load_lds((const unsigned*)((const char*)(gbase) + (voff)[_i]), (PG8_LAS unsigned*)(lds + (bufoff) + ldsw + _i * 8192), 16, 0, 0); } while (0)
#define PG8_LDA(dst, b, h) do { _Pragma("unroll") for (int m = 0; m < 4; ++m) _Pragma("unroll") for (int k = 0; k < 2; ++k) dst[m][k] = *(const PG8_LAS bf16x8*)(lds + PG8_SA(b, h) + aoff + m * 2048 + k * 1024); } while (0)
#define PG8_LDB(dst, b, h) do { _Pragma("unroll") for (int n = 0; n < 2; ++n) _Pragma("unroll") for (int k = 0; k < 2; ++k) dst[n][k] = *(const PG8_LAS bf16x8*)(lds + PG8_SB(b, h) + boff + n * 2048 + k * 1024); } while (0)
#define PG8_MMA(ai, bj, At, Bt) do { __builtin_amdgcn_s_setprio(1); _Pragma("unroll") for (int m = 0; m < 4; ++m) _Pragma("unroll") for (int n = 0; n < 2; ++n) _Pragma("unroll") for (int k = 0; k < 2; ++k) \
        acc[ai][bj][m][n] = __builtin_amdgcn_mfma_f32_16x16x32_bf16(Bt[n][k], At[m][k], acc[ai][bj][m][n], 0, 0, 0); __builtin_amdgcn_s_setprio(0); } while (0)
#define PG8_WAIT_V(n) asm volatile("s_waitcnt vmcnt(" #n ")" ::: "memory")
#define PG8_WAIT_L(n) asm volatile("s_waitcnt lgkmcnt(" #n ")" ::: "memory")
#define PG8_BAR __builtin_amdgcn_s_barrier()
#define PG8_SCHED __builtin_amdgcn_sched_barrier(0)
    Unit cur, nxt; int ui = 0;
    if (!S.next(0, cur)) return;
    f32x4 acc[2][2][4][2];
#pragma unroll
    for (int a = 0; a < 2; ++a)
#pragma unroll
        for (int b = 0; b < 2; ++b)
#pragma unroll
            for (int m = 0; m < 4; ++m)
#pragma unroll
                for (int n = 0; n < 2; ++n) acc[a][b][m][n] = (f32x4){0.f, 0.f, 0.f, 0.f};
    bf16x8 At[4][2], B0[2][2], B1[2][2];
    const char* cA = (const char*)g.A + (size_t)cur.pm * tstep; const char* cB = (const char*)g.Bt + (size_t)cur.pn * tstep;
    S.a_ready(cur);
    if constexpr (SP2) {
        PG8_STAGE(PG8_SB(0, 0), cB, voffB); PG8_STAGE(PG8_SB(0, 1), cB + hstep, voffB); PG8_STAGE(PG8_SA(0, 0), cA, voffA); PG8_STAGE(PG8_SA(0, 1), cA + hstep, voffA);
        if (wr == 1) PG8_BAR;
        PG8_WAIT_V(2); PG8_BAR;
        PG8_STAGE(PG8_SB(1, 0), cB + kstep, voffB); PG8_STAGE(PG8_SA(1, 0), cA + kstep, voffA); PG8_STAGE(PG8_SB(1, 1), cB + hstep + kstep, voffB);
        PG8_WAIT_V(6); PG8_BAR;
    } else {
        PG8_STAGE(PG8_SB(0, 0), cB, voffB); PG8_STAGE(PG8_SA(0, 0), cA, voffA); PG8_STAGE(PG8_SB(0, 1), cB + hstep, voffB); PG8_STAGE(PG8_SA(0, 1), cA + hstep, voffA);
        if (wr == 1) PG8_BAR;
        PG8_WAIT_V(4); PG8_BAR;
        PG8_STAGE(PG8_SB(1, 0), cB + kstep, voffB); PG8_STAGE(PG8_SA(1, 0), cA + kstep, voffA); PG8_STAGE(PG8_SB(1, 1), cB + hstep + kstep, voffB);
        PG8_WAIT_V(6); PG8_BAR;
    }
    for (;;) {
        const bool has_next = S.next(ui + 1, nxt);
        const char* nA = has_next ? (const char*)g.A + (size_t)nxt.pm * tstep : cA; const char* nB = has_next ? (const char*)g.Bt + (size_t)nxt.pn * tstep : cB;
        _Pragma("unroll 1") for (int t = 0; t < nt; t += 2) {
            const bool last = (t == nt - 2);
            const char* a1 = cA + (size_t)(t + 1) * kstep;
            const char* a2 = last ? nA : cA + (size_t)(t + 2) * kstep; const char* b2 = last ? nB : cB + (size_t)(t + 2) * kstep;
            const char* a3 = a2 + kstep; const char* b3 = b2 + kstep;
            if (last && has_next) S.a_ready(nxt);
            if constexpr (Epi::HAS_MID) { if (t == (nt >> 1)) E.mid(acc, cur, wr, wc, fr, fq); }
            if constexpr (SP2) {
            PG8_LDB(B0, 0, 0); PG8_LDB(B1, 0, 1); PG8_SCHED; PG8_LDA(At, 0, 0); PG8_STAGE(PG8_SA(1, 1), a1 + hstep, voffA);
            PG8_WAIT_V(8); PG8_WAIT_L(0); PG8_BAR; PG8_MMA(0, 0, At, B0); PG8_MMA(0, 1, At, B1); PG8_BAR; PG8_SCHED;
            PG8_LDA(At, 0, 1); PG8_STAGE(PG8_SB(0, 0), b2, voffB); PG8_STAGE(PG8_SB(0, 1), b2 + hstep, voffB); PG8_STAGE(PG8_SA(0, 0), a2, voffA);
            PG8_WAIT_V(8); PG8_WAIT_L(0); PG8_BAR; PG8_MMA(1, 0, At, B0); PG8_MMA(1, 1, At, B1); PG8_BAR; PG8_SCHED;
            PG8_LDB(B0, 1, 0); PG8_LDB(B1, 1, 1); PG8_SCHED; PG8_LDA(At, 1, 0); PG8_STAGE(PG8_SA(0, 1), a2 + hstep, voffA);
            PG8_WAIT_V(8); PG8_WAIT_L(0); PG8_BAR; PG8_MMA(0, 0, At, B0); PG8_MMA(0, 1, At, B1); PG8_BAR; PG8_SCHED;
            PG8_LDA(At, 1, 1); PG8_STAGE(PG8_SB(1, 0), b3, voffB); PG8_STAGE(PG8_SB(1, 1), b3 + hstep, voffB); PG8_STAGE(PG8_SA(1, 0), a3, voffA);
            PG8_WAIT_V(8); PG8_WAIT_L(0); PG8_BAR; PG8_MMA(1, 0, At, B0); PG8_MMA(1, 1, At, B1); PG8_BAR; PG8_SCHED;
            } else {
            PG8_LDB(B0, 0, 0); PG8_SCHED; PG8_LDA(At, 0, 0); PG8_STAGE(PG8_SA(1, 1), a1 + hstep, voffA);
            PG8_WAIT_L(8); PG8_BAR; PG8_WAIT_L(0); PG8_MMA(0, 0, At, B0); PG8_BAR; PG8_SCHED;
            PG8_LDB(B1, 0, 1); PG8_STAGE(PG8_SB(0, 0), b2, voffB);
            PG8_BAR; PG8_WAIT_L(0); PG8_MMA(0, 1, At, B1); PG8_BAR;
            PG8_LDA(At, 0, 1); PG8_STAGE(PG8_SA(0, 0), a2, voffA);
            PG8_BAR; PG8_WAIT_L(0); PG8_MMA(1, 0, At, B0); PG8_BAR; PG8_SCHED;
            PG8_STAGE(PG8_SB(0, 1), b2 + hstep, voffB);
            PG8_WAIT_V(6); PG8_BAR; PG8_MMA(1, 1, At, B1); PG8_BAR;
            PG8_LDB(B0, 1, 0); PG8_SCHED; PG8_LDA(At, 1, 0); PG8_STAGE(PG8_SA(0, 1), a2 + hstep, voffA);
            PG8_WAIT_L(8); PG8_BAR; PG8_WAIT_L(0); PG8_MMA(0, 0, At, B0); PG8_BAR; PG8_SCHED;
            PG8_LDB(B1, 1, 1); PG8_STAGE(PG8_SB(1, 0), b3, voffB);
            PG8_BAR; PG8_WAIT_L(0); PG8_MMA(0, 1, At, B1); PG8_BAR;
            PG8_LDA(At, 1, 1); PG8_STAGE(PG8_SA(1, 0), a3, voffA);
            PG8_BAR; PG8_WAIT_L(0); PG8_MMA(1, 0, At, B0); PG8_BAR; PG8_SCHED;
            PG8_STAGE(PG8_SB(1, 1), b3 + hstep, voffB);
            PG8_WAIT_V(6); PG8_BAR; PG8_MMA(1, 1, At, B1); PG8_BAR;
            }
        }
        if constexpr (ALIGN_EPI) { if (wr == 0) PG8_BAR; }
        if constexpr (!Epi::AFTER_DRAIN) { E(acc, cur, wr, wc, fr, fq); S.done(cur); }
        if (!has_next) break;
#pragma unroll
        for (int a = 0; a < 2; ++a)
#pragma unroll
            for (int b = 0; b < 2; ++b)
#pragma unroll
                for (int m = 0; m < 4; ++m)
#pragma unroll
                    for (int n = 0; n < 2; ++n) acc[a][b][m][n] = (f32x4){0.f, 0.f, 0.f, 0.f};
        cur = nxt; cA = nA; cB = nB; ++ui;
        if constexpr (ALIGN_EPI) { if (wr == 1) PG8_BAR; }
    }
    PG8_WAIT_V(0);
    if constexpr (!ALIGN_EPI) { if (wr == 0) PG8_BAR; }
    PG8_BAR;
    if constexpr (Epi::AFTER_DRAIN) { E.fused(acc, cur, wr, wc, fr, fq, lds, wid, lane); S.done(cur); }
#undef PG8_SA
#undef PG8_SB
#undef PG8_STAGE
#undef PG8_LDA
#undef PG8_LDB
#undef PG8_MMA
#undef PG8_WAIT_V
#undef PG8_WAIT_L
#undef PG8_BAR
#undef PG8_SCHED
}
}

#ifndef MK_N_LAUNCHES
#define MK_N_LAUNCHES 1
#endif
#ifndef DBG_SKIP_HGRN
#define DBG_SKIP_HGRN 0
#endif
#ifndef P1_ALIGN
#define P1_ALIGN true
#endif
#ifndef P1_SP2
#define P1_SP2 true
#endif
#ifndef DBG_SKIP_DSA
#define DBG_SKIP_DSA 0
#endif

#define GAS __attribute__((address_space(1)))
#define LAS __attribute__((address_space(3)))
typedef unsigned short bf16;
typedef unsigned v4u __attribute__((ext_vector_type(4)));
typedef unsigned v2u __attribute__((ext_vector_type(2)));
typedef float f32x4 __attribute__((ext_vector_type(4)));
typedef short bf16x8 __attribute__((ext_vector_type(8)));
typedef _Float16 h2 __attribute__((ext_vector_type(2)));
typedef _Float16 h8 __attribute__((ext_vector_type(8)));
typedef GAS unsigned gu32;

constexpr int NWAVES = 8, NTHR = 512;
constexpr int BATCH = 4, SEQ = 8192, DM = 1024, M = BATCH * SEQ;
constexpr int HGW = 512, HGD = 128;
constexpr int NPROJ = 4864;
constexpr int DFF = 4096;
constexpr float EPS = 1e-6f;
constexpr int NPHASE = 10;

constexpr size_t MiB = 1u << 20;
constexpr size_t WS_CTL = 0, CTL_ZERO_BYTES = 1 * MiB;
constexpr size_t WS_WIN = 1 * MiB;
constexpr size_t WS_LB = 10 * MiB + 768 * 1024;
constexpr size_t WS_WQI = 11 * MiB;
constexpr size_t WS_WMH = 12 * MiB;
constexpr size_t WS_WMA = 13 * MiB;
constexpr size_t WS_WO = 14 * MiB;
constexpr size_t WS_WMI = 16 * MiB;
constexpr size_t WS_WMO = 24 * MiB;
constexpr size_t WS_GA = 32 * MiB;
constexpr size_t WS_GB = 96 * MiB;
constexpr size_t WS_QH = 160 * MiB;
constexpr size_t WS_G = 192 * MiB;
constexpr size_t WS_VH = 256 * MiB;
constexpr size_t WS_SG = 288 * MiB;
constexpr size_t WS_CQ = 320 * MiB;
constexpr size_t WS_OB = 320 * MiB;
constexpr size_t WS_KV = 352 * MiB;
constexpr size_t WS_IKW = 368 * MiB;
constexpr size_t WS_CQN = 384 * MiB;
constexpr size_t WS_IKN = 400 * MiB;
constexpr size_t WS_HM = 416 * MiB;
constexpr size_t WS_XG = 32 * MiB;
constexpr size_t WS_AQ = 416 * MiB;
constexpr size_t WS_IQ = 448 * MiB;
constexpr size_t WS_MIX = 416 * MiB;
constexpr size_t WS_OA = 480 * MiB;
constexpr size_t WS_MIXP = 160 * MiB;
constexpr size_t WS_HID = 160 * MiB;
constexpr size_t WS_END = 512 * MiB;
constexpr size_t OAB_OFF = 32 * MiB;

constexpr int CW_Q = 64;
constexpr int CW_BAR = 4096;
constexpr int CW_ROWSS2 = 131072 + 32768;
constexpr int CW_PCNT = 131072 + 65536;
static_assert((CW_PCNT + 128) * 4 <= (int)CTL_ZERO_BYTES, "ctl region");
constexpr int CW_ROWSS = 131072;

constexpr int LDS_BYTES = 163840 - 1024;
constexpr int MISC_OFF = LDS_BYTES - 256;

#define LDS_WAIT() asm volatile("s_waitcnt lgkmcnt(0)" ::: "memory")
#define VM_WAIT() asm volatile("s_waitcnt vmcnt(0)" ::: "memory")
__device__ __forceinline__ unsigned f2bf(float f) { const __bf16 b = (__bf16)f; return (unsigned)__builtin_bit_cast(unsigned short, b); }
__device__ __forceinline__ unsigned pk2(float lo, float hi) { return pg8::cvt_pk_bf16(lo, hi); }
__device__ __forceinline__ float bf2f(unsigned short b) { return __builtin_bit_cast(float, ((unsigned)b) << 16); }
__device__ __forceinline__ float bflo(unsigned u) { return __builtin_bit_cast(float, u << 16); }
__device__ __forceinline__ float bfhi(unsigned u) { return __builtin_bit_cast(float, u & 0xffff0000u); }
__device__ __forceinline__ float wave_sum(float v) {
#pragma unroll
    for (int o = 1; o < 64; o <<= 1) v += __shfl_xor(v, o);
    return v;
}
__device__ __forceinline__ float sigmoidf_(float z) { return __builtin_amdgcn_rcpf(1.0f + __expf(-z)); }

struct Args { const float* in[18]; float* out; unsigned char* ws; int ph_lo, ph_hi, fuse; };

namespace epi {
#ifndef NT_STORES
#define NT_STORES 0
#endif
#if NT_STORES
#define ST_STREAM(ptr, val) __builtin_nontemporal_store((val), (ptr))
#else
#define ST_STREAM(ptr, val) (*(ptr) = (val))
#endif
using pg8::f32x4; using pg8::u32x4; using pg8::Unit; using pg8::cvt_pk_bf16; using pg8::bf16_t;
enum { X_NONE = 0, X_SIG = 1, X_SILU = 2, X_RELU2 = 3 };
template <int X> __device__ __forceinline__ float xf(float v) {
#ifdef DBG_CONSTGATE
    if (X == X_SIG) return 0.5f + 0.0f * fminf(fmaxf(v, -1.f), 1.f);
#endif
    if (X == X_SIG) return sigmoidf_(v);
    if (X == X_SILU) return v * sigmoidf_(v);
    if (X == X_RELU2) { const float r = fmaxf(v, 0.f); return r * r; }
    return v;
}
template <int X> __device__ __forceinline__ void store_bf16(const f32x4 (&acc)[2][2][4][2], bf16_t* base, int ldc, int row0, int col0, float sc) {
#pragma unroll
    for (int ai = 0; ai < 2; ++ai)
#pragma unroll
        for (int m = 0; m < 4; ++m) { bf16_t* rowp = base + (size_t)(row0 + ai * 128 + m * 16) * ldc + col0;
#pragma unroll
            for (int bj = 0; bj < 2; ++bj) { const f32x4 v0 = acc[ai][bj][m][0], v1 = acc[ai][bj][m][1];
                u32x4 w; w.x = cvt_pk_bf16(xf<X>(v0[0]) * sc, xf<X>(v0[1]) * sc); w.y = cvt_pk_bf16(xf<X>(v0[2]) * sc, xf<X>(v0[3]) * sc);
                w.z = cvt_pk_bf16(xf<X>(v1[0]) * sc, xf<X>(v1[1]) * sc); w.w = cvt_pk_bf16(xf<X>(v1[2]) * sc, xf<X>(v1[3]) * sc);
                *(u32x4*)(rowp + bj * 128) = w; } }
}
template <int B> __device__ __forceinline__ float ubf(unsigned x) { return (float)((x >> (8 * B)) & 255u); }
__device__ __forceinline__ void store_gate_u8(const f32x4 (&acc)[2][2][4][2], unsigned char* base, int ldc, int row0, int col0, float qmin) {
#pragma unroll
    for (int ai = 0; ai < 2; ++ai)
#pragma unroll
        for (int m = 0; m < 4; ++m) { unsigned char* rowp = base + (size_t)(row0 + ai * 128 + m * 16) * ldc + col0;
#pragma unroll
            for (int bj = 0; bj < 2; ++bj) { unsigned w[2];
#pragma unroll
                for (int n = 0; n < 2; ++n) { const f32x4 v = acc[ai][bj][m][n]; unsigned p = 0u;
                    p = __builtin_amdgcn_cvt_pk_u8_f32(fmaxf(xf<X_SIG>(v[0]) * 255.f, qmin), 0u, p); p = __builtin_amdgcn_cvt_pk_u8_f32(fmaxf(xf<X_SIG>(v[1]) * 255.f, qmin), 1u, p);
                    p = __builtin_amdgcn_cvt_pk_u8_f32(fmaxf(xf<X_SIG>(v[2]) * 255.f, qmin), 2u, p); p = __builtin_amdgcn_cvt_pk_u8_f32(fmaxf(xf<X_SIG>(v[3]) * 255.f, qmin), 3u, p);
                    w[n] = p; }
                *(v2u*)(rowp + bj * 128) = (v2u){w[0], w[1]}; } }
}
__device__ __forceinline__ unsigned pkh2(float a, float b) { h2 t; t.x = (_Float16)a; t.y = (_Float16)b; return __builtin_bit_cast(unsigned, t); }
__device__ __forceinline__ void store_f16(const f32x4 (&acc)[2][2][4][2], unsigned short* base, int ldc, int row0, int col0, float sc) {
#pragma unroll
    for (int ai = 0; ai < 2; ++ai)
#pragma unroll
        for (int m = 0; m < 4; ++m) { unsigned short* rowp = base + (size_t)(row0 + ai * 128 + m * 16) * ldc + col0;
#pragma unroll
            for (int bj = 0; bj < 2; ++bj) { const f32x4 v0 = acc[ai][bj][m][0], v1 = acc[ai][bj][m][1];
                u32x4 w; w.x = pkh2(v0[0] * sc, v0[1] * sc); w.y = pkh2(v0[2] * sc, v0[3] * sc); w.z = pkh2(v1[0] * sc, v1[1] * sc); w.w = pkh2(v1[2] * sc, v1[3] * sc);
                *(u32x4*)(rowp + bj * 128) = w; }
            asm volatile("" ::: "memory"); }
}
template <int NBJ> __device__ __forceinline__ void store_f32(const f32x4 (&acc)[2][2][4][2], float* base, int ldc, int row0, int col0) {
#pragma unroll
    for (int ai = 0; ai < 2; ++ai)
#pragma unroll
        for (int m = 0; m < 4; ++m) { float* rowp = base + (size_t)(row0 + ai * 128 + m * 16) * ldc + col0;
#pragma unroll
            for (int bj = 0; bj < NBJ; ++bj) { *(f32x4*)(rowp + bj * 128) = acc[ai][bj][m][0]; *(f32x4*)(rowp + bj * 128 + 4) = acc[ai][bj][m][1]; } }
}

struct EpiProj {
    static constexpr bool PERM = true, AFTER_DRAIN = false, HAS_MID = false;
    unsigned char* ws;
    __device__ __forceinline__ void operator()(const f32x4 (&acc)[2][2][4][2], const Unit& u, int wr, int wc, int fr, int fq) const {
        const int row0 = u.pm * 256 + wr * 64 + fr, cl = wc * 32 + 8 * fq, pn = u.pn;
        if (pn < 2) store_bf16<X_NONE>(acc, (bf16_t*)(ws + WS_QH), 512, row0, pn * 256 + cl, 1.f);
        else if (pn < 4) {
            float* G = (float*)(ws + WS_G); const float* lb = (const float*)(ws + WS_LB); const int cb = (pn - 2) * 256 + cl;
            f32x4 lbv[2][2];
#pragma unroll
            for (int bj = 0; bj < 2; ++bj)
#pragma unroll
                for (int n = 0; n < 2; ++n) lbv[bj][n] = *(const f32x4*)(lb + cb + bj * 128 + 4 * n);
#pragma unroll
            for (int ai = 0; ai < 2; ++ai)
#pragma unroll
                for (int m = 0; m < 4; ++m) { float* rowp = G + (size_t)(row0 + ai * 128 + m * 16) * 512 + cb;
#pragma unroll
                    for (int bj = 0; bj < 2; ++bj)
#pragma unroll
                        for (int n = 0; n < 2; ++n) { f32x4 o;
#pragma unroll
                            for (int j = 0; j < 4; ++j) { const float l = lbv[bj][n][j]; o[j] = __logf(l + (1.0f - l) * sigmoidf_(acc[ai][bj][m][n][j])); }
                            *(f32x4*)(rowp + bj * 128 + 4 * n) = o; } }
        }
        else if (pn < 6) store_bf16<X_NONE>(acc, (bf16_t*)(ws + WS_VH), 512, row0, (pn - 4) * 256 + cl, 1.f);
        else if (pn < 8) store_bf16<X_SILU>(acc, (bf16_t*)(ws + WS_SG), 512, row0, (pn - 6) * 256 + cl, 1.f);
        else if (pn < 12) store_gate_u8(acc, ws + WS_GA, 1024, row0, (pn - 8) * 256 + cl, 0.f);
        else if (pn < 16) store_gate_u8(acc, ws + WS_GB, 1024, row0, (pn - 12) * 256 + cl, 1.f);
        else if (pn == 16) store_f32<2>(acc, (float*)(ws + WS_CQ), 256, row0, cl);
        else if (pn == 17) {
            unsigned char* KV8 = ws + WS_KV;
#pragma unroll
            for (int ai = 0; ai < 2; ++ai)
#pragma unroll
                for (int m = 0; m < 4; ++m) { unsigned char* rowp = KV8 + (size_t)(row0 + ai * 128 + m * 16) * 256;
#pragma unroll
                    for (int bj = 0; bj < 2; ++bj) { const f32x4 v0 = acc[ai][bj][m][0], v1 = acc[ai][bj][m][1];
                        int w0 = __builtin_amdgcn_cvt_pk_fp8_f32(v0[0], v0[1], 0, false); w0 = __builtin_amdgcn_cvt_pk_fp8_f32(v0[2], v0[3], w0, true);
                        int w1 = __builtin_amdgcn_cvt_pk_fp8_f32(v1[0], v1[1], 0, false); w1 = __builtin_amdgcn_cvt_pk_fp8_f32(v1[2], v1[3], w1, true);
                        const int dst = bj == 0 ? (fq * 32 + wc * 8) : (128 + cl);
                        *(v2u*)(rowp + dst) = (v2u){(unsigned)w0, (unsigned)w1}; } }
        }
        else store_f32<1>(acc, (float*)(ws + WS_IKW), 128, row0, cl);
    }
};
struct EpiQI {
    static constexpr bool PERM = true, AFTER_DRAIN = false, HAS_MID = false;
    unsigned char* ws;
    __device__ __forceinline__ void operator()(const f32x4 (&acc)[2][2][4][2], const Unit& u, int wr, int wc, int fr, int fq) const {
        const int row0 = u.pm * 256 + wr * 64 + fr, cl = wc * 32 + 8 * fq, pn = u.pn;
        if (pn < 2) store_bf16<X_NONE>(acc, (bf16_t*)(ws + WS_AQ), 512, row0, pn * 256 + cl, 0.125f);
        else store_f16(acc, (unsigned short*)(ws + WS_IQ), 512, row0, (pn - 2) * 256 + cl, 0.125f);
    }
};
struct EpiMixM {
    static constexpr bool PERM = true, AFTER_DRAIN = false, HAS_MID = true;
    unsigned char* ws;
    __device__ __forceinline__ void mid(f32x4 (&acc)[2][2][4][2], const Unit& u, int wr, int wc, int fr, int fq) const {
        int row0 = u.pm * 256 + wr * 64 + fr, col0 = u.pn * 256 + wc * 32 + 8 * fq;
        asm volatile("" : "+v"(row0), "+v"(col0));
        const unsigned char* GA = ws + WS_GA; const unsigned char* GB = ws + WS_GB;
#pragma unroll
        for (int ai = 0; ai < 2; ++ai) {
            v2u ga[4][2], gb[4][2];
#pragma unroll
            for (int m = 0; m < 4; ++m) { const size_t off = (size_t)(row0 + ai * 128 + m * 16) * 1024 + col0;
#pragma unroll
                for (int bj = 0; bj < 2; ++bj) { ga[m][bj] = *(const v2u*)(GA + off + bj * 128); gb[m][bj] = *(const v2u*)(GB + off + bj * 128); } }
#pragma unroll
            for (int m = 0; m < 4; ++m)
#pragma unroll
                for (int bj = 0; bj < 2; ++bj) { const v2u a = ga[m][bj], b = gb[m][bj];
                    f32x4& v0 = acc[ai][bj][m][0]; f32x4& v1 = acc[ai][bj][m][1];
                    v0[0] *= ubf<0>(a.x) * __builtin_amdgcn_rcpf(ubf<0>(b.x)); v0[1] *= ubf<1>(a.x) * __builtin_amdgcn_rcpf(ubf<1>(b.x));
                    v0[2] *= ubf<2>(a.x) * __builtin_amdgcn_rcpf(ubf<2>(b.x)); v0[3] *= ubf<3>(a.x) * __builtin_amdgcn_rcpf(ubf<3>(b.x));
                    v1[0] *= ubf<0>(a.y) * __builtin_amdgcn_rcpf(ubf<0>(b.y)); v1[1] *= ubf<1>(a.y) * __builtin_amdgcn_rcpf(ubf<1>(b.y));
                    v1[2] *= ubf<2>(a.y) * __builtin_amdgcn_rcpf(ubf<2>(b.y)); v1[3] *= ubf<3>(a.y) * __builtin_amdgcn_rcpf(ubf<3>(b.y)); }
            asm volatile("" ::: "memory"); }
    }
    __device__ __forceinline__ void operator()(const f32x4 (&acc)[2][2][4][2], const Unit& u, int wr, int wc, int fr, int fq) const {
        const int row0 = u.pm * 256 + wr * 64 + fr, col0 = u.pn * 256 + wc * 32 + 8 * fq;
        const unsigned char* GB = ws + WS_GB; bf16_t* out = (bf16_t*)(ws + WS_MIX); constexpr float Q = 1.0f / 255.0f;
#pragma unroll
        for (int ai = 0; ai < 2; ++ai)
#pragma unroll
            for (int m = 0; m < 4; ++m) { const size_t off = (size_t)(row0 + ai * 128 + m * 16) * 1024 + col0;
#pragma unroll
                for (int bj = 0; bj < 2; ++bj) { const v2u gv = *(const v2u*)(GB + off + bj * 128);
                    const f32x4 v0 = acc[ai][bj][m][0] * Q, v1 = acc[ai][bj][m][1] * Q; u32x4 w;
                    w.x = cvt_pk_bf16(ubf<0>(gv.x) * v0[0], ubf<1>(gv.x) * v0[1]); w.y = cvt_pk_bf16(ubf<2>(gv.x) * v0[2], ubf<3>(gv.x) * v0[3]);
                    w.z = cvt_pk_bf16(ubf<0>(gv.y) * v1[0], ubf<1>(gv.y) * v1[1]); w.w = cvt_pk_bf16(ubf<2>(gv.y) * v1[2], ubf<3>(gv.y) * v1[3]);
                    ST_STREAM((u32x4*)(out + off + bj * 128), w); }
                if (m == 3) asm volatile("" ::: "memory"); }
    }
};
struct EpiWo {
    static constexpr bool PERM = true, AFTER_DRAIN = false, HAS_MID = false;
    const float* base; bf16_t* x1b; float* rowss;
    __device__ __forceinline__ void operator()(const f32x4 (&acc)[2][2][4][2], const Unit& u, int wr, int wc, int fr, int fq) const {
        const int row0 = u.pm * 256 + wr * 64 + fr, col0 = u.pn * 256 + wc * 32 + 8 * fq;
#pragma unroll
        for (int ai = 0; ai < 2; ++ai)
#pragma unroll
            for (int m = 0; m < 4; ++m) { const int row = row0 + ai * 128 + m * 16; const size_t off = (size_t)row * 1024 + col0; float ss = 0.f;
#pragma unroll
                for (int bj = 0; bj < 2; ++bj) {
                    const f32x4 x0 = *(const f32x4*)(base + off + bj * 128) + acc[ai][bj][m][0], x1 = *(const f32x4*)(base + off + bj * 128 + 4) + acc[ai][bj][m][1];
                    ss += (x0[0] * x0[0] + x0[1] * x0[1]) + (x0[2] * x0[2] + x0[3] * x0[3]) + (x1[0] * x1[0] + x1[1] * x1[1]) + (x1[2] * x1[2] + x1[3] * x1[3]);
                    u32x4 w; w.x = cvt_pk_bf16(x0[0], x0[1]); w.y = cvt_pk_bf16(x0[2], x0[3]); w.z = cvt_pk_bf16(x1[0], x1[1]); w.w = cvt_pk_bf16(x1[2], x1[3]);
                    ST_STREAM((u32x4*)(x1b + off + bj * 128), w); }
                ss += __shfl_xor(ss, 16); ss += __shfl_xor(ss, 32);
                if (fq == 0) atomicAdd(rowss + row, ss);
                if (m & 1) asm volatile("" ::: "memory"); }
    }
};
struct EpiResid {
    static constexpr bool PERM = true, AFTER_DRAIN = false, HAS_MID = false;
    const bf16_t* base; float* out;
    __device__ __forceinline__ void operator()(const f32x4 (&acc)[2][2][4][2], const Unit& u, int wr, int wc, int fr, int fq) const {
        const int row0 = u.pm * 256 + wr * 64 + fr, col0 = u.pn * 256 + wc * 32 + 8 * fq;
#pragma unroll
        for (int ai = 0; ai < 2; ++ai)
#pragma unroll
            for (int m = 0; m < 4; ++m) { const size_t off = (size_t)(row0 + ai * 128 + m * 16) * 1024 + col0;
#pragma unroll
                for (int bj = 0; bj < 2; ++bj) {
                    const u32x4 bb = *(const u32x4*)(base + off + bj * 128);
                    const f32x4 b0 = (f32x4){bflo(bb.x), bfhi(bb.x), bflo(bb.y), bfhi(bb.y)}, b1 = (f32x4){bflo(bb.z), bfhi(bb.z), bflo(bb.w), bfhi(bb.w)};
                    *(f32x4*)(out + off + bj * 128) = b0 + acc[ai][bj][m][0]; *(f32x4*)(out + off + bj * 128 + 4) = b1 + acc[ai][bj][m][1]; }
                if (m & 1) asm volatile("" ::: "memory"); }
    }
};
struct EpiFinal {
    static constexpr bool PERM = true, AFTER_DRAIN = false, HAS_MID = false;
    const bf16_t* base; float* out; const float* gain; float* rowss; unsigned* pcnt;
    __device__ __forceinline__ void operator()(f32x4 (&acc)[2][2][4][2], const Unit& u, int wr, int wc, int fr, int fq) const {
        const int row0 = u.pm * 256 + wr * 64 + fr, col0 = u.pn * 256 + wc * 32 + 8 * fq; float dummy = 0.f;
#pragma unroll
        for (int ai = 0; ai < 2; ++ai)
#pragma unroll
            for (int m = 0; m < 4; ++m) { const int row = row0 + ai * 128 + m * 16; const size_t off = (size_t)row * 1024 + col0; float ss = 0.f;
#pragma unroll
                for (int bj = 0; bj < 2; ++bj) {
                    const u32x4 bb = *(const u32x4*)(base + off + bj * 128);
                    const f32x4 x0 = (f32x4){bflo(bb.x), bfhi(bb.x), bflo(bb.y), bfhi(bb.y)} + acc[ai][bj][m][0], x1 = (f32x4){bflo(bb.z), bfhi(bb.z), bflo(bb.w), bfhi(bb.w)} + acc[ai][bj][m][1];
                    acc[ai][bj][m][0] = x0; acc[ai][bj][m][1] = x1;
                    ss += (x0[0] * x0[0] + x0[1] * x0[1]) + (x0[2] * x0[2] + x0[3] * x0[3]) + (x1[0] * x1[0] + x1[1] * x1[1]) + (x1[2] * x1[2] + x1[3] * x1[3]); }
                ss += __shfl_xor(ss, 16); ss += __shfl_xor(ss, 32);
                if (fq == 0) dummy += __hip_atomic_fetch_add(rowss + row, ss, __ATOMIC_RELAXED, __HIP_MEMORY_SCOPE_AGENT);
                if (m & 1) asm volatile("" ::: "memory"); }
        asm volatile("s_waitcnt vmcnt(0)" :: "v"(dummy) : "memory");
        __builtin_amdgcn_s_barrier();
        if ((wr | wc | fr | fq) == 0) {
            (void)__hip_atomic_fetch_add(pcnt + u.pm, 1u, __ATOMIC_RELAXED, __HIP_MEMORY_SCOPE_AGENT);
            while (__hip_atomic_load(pcnt + u.pm, __ATOMIC_RELAXED, __HIP_MEMORY_SCOPE_AGENT) < 4u) __builtin_amdgcn_s_sleep(1);
        }
        asm volatile("" ::: "memory");
        __builtin_amdgcn_s_barrier();
        asm volatile("" ::: "memory");
        f32x4 gv[2][2];
#pragma unroll
        for (int bj = 0; bj < 2; ++bj) { gv[bj][0] = *(const f32x4*)(gain + col0 + bj * 128); gv[bj][1] = *(const f32x4*)(gain + col0 + bj * 128 + 4); }
#pragma unroll
        for (int ai = 0; ai < 2; ++ai)
#pragma unroll
            for (int m = 0; m < 4; ++m) { const int row = row0 + ai * 128 + m * 16; const size_t off = (size_t)row * 1024 + col0;
                const float rstd = 1.0f / sqrtf(__hip_atomic_load(rowss + row, __ATOMIC_RELAXED, __HIP_MEMORY_SCOPE_AGENT) * (1.f / 1024.f) + EPS);
#pragma unroll
                for (int bj = 0; bj < 2; ++bj) { ST_STREAM((f32x4*)(out + off + bj * 128), acc[ai][bj][m][0] * rstd * gv[bj][0]); ST_STREAM((f32x4*)(out + off + bj * 128 + 4), acc[ai][bj][m][1] * rstd * gv[bj][1]); }
                if (m & 1) asm volatile("" ::: "memory"); }
    }
};
struct EpiRelu2 {
    static constexpr bool PERM = true, AFTER_DRAIN = false, HAS_MID = false;
    bf16_t* out; const float* rowss;
    __device__ __forceinline__ void operator()(const f32x4 (&acc)[2][2][4][2], const Unit& u, int wr, int wc, int fr, int fq) const {
        const int row0 = u.pm * 256 + wr * 64 + fr, col0 = u.pn * 256 + wc * 32 + 8 * fq;
#pragma unroll
        for (int ai = 0; ai < 2; ++ai)
#pragma unroll
            for (int m = 0; m < 4; ++m) { const int row = row0 + ai * 128 + m * 16; bf16_t* rowp = out + (size_t)row * DFF + col0;
                const float rstd = 1.0f / sqrtf(rowss[row] * (1.f / 1024.f) + EPS);
#pragma unroll
                for (int bj = 0; bj < 2; ++bj) { const f32x4 v0 = acc[ai][bj][m][0] * rstd, v1 = acc[ai][bj][m][1] * rstd;
                    u32x4 w; w.x = cvt_pk_bf16(xf<X_RELU2>(v0[0]), xf<X_RELU2>(v0[1])); w.y = cvt_pk_bf16(xf<X_RELU2>(v0[2]), xf<X_RELU2>(v0[3]));
                    w.z = cvt_pk_bf16(xf<X_RELU2>(v1[0]), xf<X_RELU2>(v1[1])); w.w = cvt_pk_bf16(xf<X_RELU2>(v1[2]), xf<X_RELU2>(v1[3]));
                    ST_STREAM((u32x4*)(rowp + bj * 128), w); } }
    }
};
}

#define XB_TMO      128
#define XB_XCNT(j)  (256  + 64 * (j))
#define XB_XSUB(j)  (1280 + 64 * (j))
#define XB_XGEN(j)  (2304 + 64 * (j))
#define XB_TOP      3328
#define XB_TOPGEN   3392
#define XCD_BAR_WORDS 3456
#define XB_SPIN_CAP (1u << 18)

__device__ __forceinline__ unsigned xb_ld(unsigned* p)              { return __hip_atomic_load(p, __ATOMIC_RELAXED, __HIP_MEMORY_SCOPE_AGENT); }
__device__ __forceinline__ unsigned xb_add(unsigned* p, unsigned v) { return __hip_atomic_fetch_add(p, v, __ATOMIC_RELAXED, __HIP_MEMORY_SCOPE_AGENT); }
__device__ __forceinline__ unsigned xb_xcc_id() { return (unsigned)__builtin_amdgcn_s_getreg((3 << 11) | 20) & 0xFu; }
#define XB_SPIN(cond, bar) do { unsigned _sp = 0; while (cond) { __builtin_amdgcn_s_sleep(1); \
    if ((++_sp & 255u) == 0u) { if (xb_ld(&(bar)[XB_TMO])) break; if (_sp > XB_SPIN_CAP) { atomicAdd(&(bar)[XB_TMO], 1u); break; } } } } while (0)

struct XcdBarrier {
    unsigned* bar; unsigned x;
    volatile LAS unsigned* st;
};

__device__ __forceinline__ XcdBarrier xcd_barrier_post(unsigned* bar, volatile LAS unsigned* st, const bool is_t0) {
    XcdBarrier b; b.bar = bar; b.x = xb_xcc_id(); b.st = st;
    if (is_t0) (void)xb_add(&bar[XB_XCNT(b.x)], 1u);
    return b;
}
__device__ __forceinline__ void xcd_barrier_complete(unsigned* bar, unsigned x, unsigned& nloc, unsigned& nx) {
    const unsigned G = gridDim.x * gridDim.y * gridDim.z;
    unsigned sum, cnt, mine, sp = 0u;
    for (;;) {
        sum = 0u; cnt = 0u; mine = 0u;
#pragma unroll
        for (unsigned j = 0; j < 16; ++j) { const unsigned c = xb_ld(&bar[XB_XCNT(j)]); sum += c; cnt += (c > 0u) ? 1u : 0u; mine = (j == x) ? c : mine; }
        if (sum == G) break;
        __builtin_amdgcn_s_sleep(1);
        if ((++sp & 255u) == 0u) { if (xb_ld(&bar[XB_TMO])) break; if (sp > XB_SPIN_CAP) { atomicAdd(&bar[XB_TMO], 1u); break; } }
    }
    nloc = mine > 0u ? mine : 1u; nx = cnt > 0u ? cnt : 1u;
}

__device__ __forceinline__ void xcd_barrier(const XcdBarrier& b, const bool is_t0) {
    asm volatile("s_waitcnt vmcnt(0)" ::: "memory");
    __syncthreads();
    if (is_t0) {
        unsigned* bar = b.bar;
        __builtin_amdgcn_s_waitcnt(0);
        unsigned nloc = b.st[0], nx = b.st[1];
        if (nloc == 0u) { xcd_barrier_complete(bar, b.x, nloc, nx); b.st[0] = nloc; b.st[1] = nx; }
        const unsigned old = xb_add(&bar[XB_XSUB(b.x)], 1u);
        const unsigned gen = old / nloc;
        if (old + 1u == (gen + 1u) * nloc) {
            __builtin_amdgcn_fence(__ATOMIC_RELEASE, "agent");
            asm volatile("s_waitcnt vmcnt(0)" ::: "memory");
            const unsigned og = xb_add(&bar[XB_TOP], 1u);
            const unsigned tg = og / nx;
            if (og + 1u == (tg + 1u) * nx) xb_add(&bar[XB_TOPGEN], 1u);
            else XB_SPIN(xb_ld(&bar[XB_TOPGEN]) == tg, bar);
            __builtin_amdgcn_fence(__ATOMIC_ACQUIRE, "agent");
            xb_add(&bar[XB_XGEN(b.x)], 1u);
            asm volatile("s_waitcnt vmcnt(0)" ::: "memory");
        } else {
            XB_SPIN(xb_ld(&bar[XB_XGEN(b.x)]) == gen, bar);
            __builtin_amdgcn_fence(__ATOMIC_ACQUIRE, "agent");
            asm volatile("s_waitcnt vmcnt(0)" ::: "memory");
        }
    }
    __syncthreads();
}

__device__ __forceinline__ int lane_fresh() { int l; asm volatile("v_mbcnt_lo_u32_b32 %0, -1, 0\n\tv_mbcnt_hi_u32_b32 %0, -1, %0" : "=v"(l)); return l; }
#define F_LANE (lane_fresh())
#define F_TID (F.wave * 64 + lane_fresh())
struct Ctx {
    LAS unsigned char* lds; int wave, G, bid;
    const float* const* in; float* out; unsigned char* ws;
};

__device__ __forceinline__ int proj_src_col(int j) {
    if (j < 2048) return j;
    if (j < 3072) return 2632 + (j - 2048);
    if (j < 4096) return 3656 + (j - 3072);
    if (j < 4352) return 2048 + (j - 4096);
    if (j < 4608) return 2304 + (j - 4352);
    if (j < 4680) return 2560 + (j - 4608);
    return -1;
}
template <bool MAPPED>
__device__ __forceinline__ void transpose_item(const float* W, int Nsrc, int K, bf16* WT, int row_off, int nblk, LAS float* scr, int item, int lane, int ldk = 0, int koff = 0, const float* kscale = nullptr) {
    if (ldk == 0) ldk = K;
    const int kb = item / nblk, nb = item % nblk, k0 = 64 * kb, n0 = 32 * nb;
    int sc = n0 + (lane & 31); if (MAPPED) sc = proj_src_col(sc);
#pragma unroll 8
    for (int i = 0; i < 32; ++i) { const int kk = 2 * i + (lane >> 5); const float ks = kscale ? kscale[k0 + kk] : 1.0f;
        scr[kk * 33 + (lane & 31)] = (sc >= 0) ? W[(size_t)(k0 + kk) * Nsrc + sc] * ks : 0.f; }
    LDS_WAIT(); asm volatile("" ::: "memory");
    const int c = lane & 7;
#pragma unroll
    for (int j = 0; j < 4; ++j) { const int n = (lane >> 3) + 8 * j; const LAS float* s = scr + (8 * c) * 33 + n;
        v4u o; o.x = pk2(s[0 * 33], s[1 * 33]); o.y = pk2(s[2 * 33], s[3 * 33]); o.z = pk2(s[4 * 33], s[5 * 33]); o.w = pk2(s[6 * 33], s[7 * 33]);
        *(GAS v4u*)(WT + (size_t)(row_off + n0 + n) * ldk + koff + k0 + 8 * c) = o; }
    LDS_WAIT(); asm volatile("" ::: "memory");
}
__device__ __forceinline__ void rms_row_to_bf16(const float* xrow, const float* gain, bf16* orow, int lane) {
    const GAS f32x4* xr = (const GAS f32x4*)xrow + lane; const GAS f32x4* gr = (const GAS f32x4*)gain + lane;
    f32x4 v[4]; float s = 0.f;
#pragma unroll
    for (int j = 0; j < 4; ++j) { v[j] = xr[64 * j]; s += (v[j].x * v[j].x + v[j].y * v[j].y) + (v[j].z * v[j].z + v[j].w * v[j].w); }
    const float rstd = 1.0f / sqrtf(wave_sum(s) * (1.f / 1024.f) + EPS);
    GAS unsigned long long* o8 = (GAS unsigned long long*)orow + lane;
#pragma unroll
    for (int j = 0; j < 4; ++j) { const f32x4 g = gr[64 * j];
        o8[64 * j] = (unsigned long long)pk2(v[j].x * rstd * g.x, v[j].y * rstd * g.y) | ((unsigned long long)pk2(v[j].z * rstd * g.z, v[j].w * rstd * g.w) << 32); }
}
__device__ __forceinline__ void p0_prologue(const Ctx& F) {
    LAS float* scr = (LAS float*)(F.lds + F.wave * 16384);
    const int gw = F.bid * NWAVES + F.wave, NGW = F.G * NWAVES;
    bf16* wt_in = (bf16*)(F.ws + WS_WIN); bf16* wt_qi = (bf16*)(F.ws + WS_WQI);
    constexpr int I_IN = 16 * 152, I_UQ = 4 * 16;
    constexpr int NITEMS = I_IN + 2 * I_UQ;
    for (int it = gw; it < NITEMS; it += NGW) {
        int r = it;
        if (r < I_IN) { transpose_item<true>(F.in[2], 4680, 1024, wt_in, 0, 152, scr, r, F_LANE); continue; } r -= I_IN;
        if (r < I_UQ) { transpose_item<false>(F.in[7], 512, 256, wt_qi, 0, 16, scr, r, F_LANE); continue; } r -= I_UQ;
        transpose_item<false>(F.in[8], 512, 256, wt_qi, 512, 16, scr, r, F_LANE);
    }
    if (F.bid == 0) {
        float* lb = (float*)(F.ws + WS_LB); const float* lg = F.in[3];
        for (int d = F_TID; d < 512; d += NTHR) lb[d] = 1.0f / (1.0f + expf(lg[512 + d] - lg[d]));
    }
    bf16* H = (bf16*)(F.ws + WS_HM);
    for (int m = gw; m < M; m += NGW) rms_row_to_bf16(F.in[0] + (size_t)m * DM, F.in[1], H + (size_t)m * DM, F_LANE);
}

constexpr int LW_MH = 8 * 32, LW_O = 16 * 32, LW_MI = 16 * 128, LW_MO = 64 * 32, LW_ITEMS = 2 * LW_MH + LW_O + LW_MI + LW_MO;
__device__ __forceinline__ void late_weight_item(const Ctx& F, int r) {
    LAS float* scr = (LAS float*)(F.lds + F.wave * 16384);
    bf16* wt_mh = (bf16*)(F.ws + WS_WMH); bf16* wt_o = (bf16*)(F.ws + WS_WO); bf16* wt_mi = (bf16*)(F.ws + WS_WMI); bf16* wt_mo = (bf16*)(F.ws + WS_WMO);
    if (r < LW_MH) { transpose_item<false>(F.in[5], 1024, 512, wt_mh, 0, 32, scr, r, F_LANE, 1024, 0); return; } r -= LW_MH;
    if (r < LW_MH) { transpose_item<false>(F.in[12], 1024, 512, wt_mh, 0, 32, scr, r, F_LANE, 1024, 512); return; } r -= LW_MH;
    if (r < LW_O) { transpose_item<false>(F.in[13], 1024, 1024, wt_o, 0, 32, scr, r, F_LANE); return; } r -= LW_O;
    if (r < LW_MI) { transpose_item<false>(F.in[15], 4096, 1024, wt_mi, 0, 128, scr, r, F_LANE, 0, 0, F.in[14]); return; } r -= LW_MI;
    transpose_item<false>(F.in[16], 1024, 4096, wt_mo, 0, 32, scr, r, F_LANE);
}

__device__ __forceinline__ void p2_norms(const Ctx& F) {
    const int gw = F.bid * NWAVES + F.wave, NGW = F.G * NWAVES, lane = F_LANE;
    const float* CQ = (const float*)(F.ws + WS_CQ); const float* IKW = (const float*)(F.ws + WS_IKW);
    bf16* CQN = (bf16*)(F.ws + WS_CQN); unsigned short* IKN = (unsigned short*)(F.ws + WS_IKN);
    const f32x4 qg = *((const GAS f32x4*)F.in[6] + lane);
    const float kg = F.in[9][lane], kb = F.in[10][lane];
    for (int m = gw; m < M; m += NGW) {
        const f32x4 v = *((const GAS f32x4*)(CQ + (size_t)m * 256) + lane);
        const float ss = wave_sum((v.x * v.x + v.y * v.y) + (v.z * v.z + v.w * v.w));
        const float rstd = 1.0f / sqrtf(ss * (1.f / 256.f) + EPS);
        *((GAS unsigned long long*)(CQN + (size_t)m * 256) + lane) = (unsigned long long)pk2(v.x * rstd * qg.x, v.y * rstd * qg.y) | ((unsigned long long)pk2(v.z * rstd * qg.z, v.w * rstd * qg.w) << 32);
        const float k = IKW[(size_t)m * 128 + lane];
        const float mu = wave_sum(k) * (1.f / 64.f); const float dk = k - mu;
        const float var = wave_sum(dk * dk) * (1.f / 64.f);
        const float y = dk * (1.0f / sqrtf(var + EPS)) * kg + kb;
        const _Float16 yh = (_Float16)y;
        IKN[(size_t)m * 64 + lane] = __builtin_bit_cast(unsigned short, yh);
    }
}
__device__ __forceinline__ void p11_final(const Ctx& F) {
    const int gw = F.bid * NWAVES + F.wave, NGW = F.G * NWAVES, lane = F_LANE;
    const GAS f32x4* gr = (const GAS f32x4*)F.in[17] + lane;
    for (int m = gw; m < M; m += NGW) {
        GAS f32x4* xr = (GAS f32x4*)(F.out + (size_t)m * DM) + lane;
        f32x4 v[4]; float s = 0.f;
#pragma unroll
        for (int j = 0; j < 4; ++j) { v[j] = xr[64 * j]; s += (v[j].x * v[j].x + v[j].y * v[j].y) + (v[j].z * v[j].z + v[j].w * v[j].w); }
        const float rstd = 1.0f / sqrtf(wave_sum(s) * (1.f / 1024.f) + EPS);
#pragma unroll
        for (int j = 0; j < 4; ++j) xr[64 * j] = v[j] * rstd * gr[64 * j];
    }
}

namespace hg {
constexpr int RS1 = 272, RS2 = 144;
constexpr int O_QA = 0, O_KA = O_QA + 64 * RS1, O_KST = O_KA + 64 * RS1, O_VT = O_KST + 128 * RS2, O_SPT = O_VT + 128 * RS2;
constexpr int O_EBM = O_SPT + 128 * RS1, O_ELA = O_EBM + 512, O_TOT = O_ELA + 512, O_RED = O_TOT + 2048, O_END = O_RED + 512;
static_assert(O_END <= 120000, "hgrn lds");
}
__device__ __forceinline__ bf16x8 lds_b128(const LAS unsigned char* p) { return *(const LAS bf16x8*)p; }
#ifndef HG_NSEG_
#define HG_NSEG_ 16
#endif
constexpr int HG_NSEG = HG_NSEG_, HG_CH = SEQ / 64 / HG_NSEG, HG_UNITS = 16 * HG_NSEG;
constexpr size_t HG_DLG_OFF = (size_t)24 * 1024 * 1024;
template <int PASS>
__device__ __forceinline__ void hgrn_segment(const Ctx& F, int bh, int seg) {
    using namespace hg;
    int lane_ = F_LANE; asm volatile("" : "+v"(lane_));
    const int b = bh >> 2, h = bh & 3, lane = lane_, w = F.wave, tid = w * 64 + lane, g = lane >> 4, c16 = lane & 15, tt = w & 3, eh = w >> 2;
    LAS unsigned char* L = F.lds;
    LAS float* eBm = (LAS float*)(L + O_EBM); LAS float* eLa = (LAS float*)(L + O_ELA); LAS float* tot = (LAS float*)(L + O_TOT); LAS float* red = (LAS float*)(L + O_RED);
    const float* Gp = (const float*)(F.ws + WS_G); const bf16* Qp = (const bf16*)(F.ws + WS_QH); const bf16* Vp = (const bf16*)(F.ws + WS_VH);
    const bf16* SGp = (const bf16*)(F.ws + WS_SG); bf16* OAp = (bf16*)((unsigned char*)F.out + OAB_OFF); const float* hgn = F.in[4];
    float* Ubuf = F.out; float* Dlg = F.out + HG_DLG_OFF;
    f32x4 S[8];
#pragma unroll
    for (int i = 0; i < 8; ++i) S[i] = (f32x4){0.f, 0.f, 0.f, 0.f};
    const int d = tid & 127, qr = tid >> 7;
    float dsum = 0.f;
    if (PASS == 2) {
        const float* up = Ubuf + ((size_t)(bh * HG_NSEG + seg) * 8 + w) * 2048 + lane * 4;
#pragma unroll
        for (int et = 0; et < 8; ++et) S[et] = *(const f32x4*)(up + et * 256);
    }
    float gN[16]; unsigned short vN[16], qN[16]; v2u sgN[4]; f32x4 gnr[4];
#define HG_FETCH(CC) { const size_t R0n = (size_t)b * SEQ + (size_t)(CC) * 64; const size_t basen = (R0n + 16 * qr) * 512 + h * 128 + d; \
        _Pragma("unroll") for (int i = 0; i < 16; ++i) { gN[i] = Gp[basen + (size_t)i * 512]; vN[i] = Vp[basen + (size_t)i * 512]; if (PASS == 2) qN[i] = Qp[basen + (size_t)i * 512]; } \
        if (PASS == 2) { const size_t rowoffn = (R0n + 16 * tt + c16) * 512 + h * 128; \
            _Pragma("unroll") for (int e4 = 0; e4 < 4; ++e4) sgN[e4] = *(const v2u*)(SGp + rowoffn + 16 * (4 * eh + e4) + 4 * g); } }
#define HG_SYNC() asm volatile("s_waitcnt lgkmcnt(0)\n\ts_barrier" ::: "memory")
    if (PASS == 2) {
#pragma unroll
        for (int e4 = 0; e4 < 4; ++e4) gnr[e4] = *(const f32x4*)(hgn + h * 128 + 16 * (4 * eh + e4) + 4 * g);
    }
    HG_FETCH(seg * HG_CH)
#pragma unroll 1
    for (int c = seg * HG_CH; c < (seg + 1) * HG_CH; ++c) {
        const size_t R0 = (size_t)b * SEQ + (size_t)c * 64;
        float gv[16], cs[16]; unsigned short qc[16]; v2u sgc[4]; f32x4 el4;
        {
            float run = 0.f;
#pragma unroll
            for (int i = 0; i < 16; ++i) { gv[i] = gN[i]; run += gv[i]; cs[i] = run; if (PASS == 2) qc[i] = qN[i]; }
            tot[qr * 128 + d] = run;
            unsigned vp[8];
#pragma unroll
            for (int i = 0; i < 8; ++i) vp[i] = (unsigned)vN[2 * i] | ((unsigned)vN[2 * i + 1] << 16);
#pragma unroll
            for (int e4 = 0; e4 < 4; ++e4) if (PASS == 2) sgc[e4] = sgN[e4];
            *(LAS v4u*)(L + O_VT + d * RS2 + qr * 32) = (v4u){vp[0], vp[1], vp[2], vp[3]};
            *(LAS v4u*)(L + O_VT + d * RS2 + qr * 32 + 16) = (v4u){vp[4], vp[5], vp[6], vp[7]};
            if (c + 1 < (seg + 1) * HG_CH) HG_FETCH(c + 1)
        }
        HG_SYNC();
        {
            const float t0 = tot[d], t1 = tot[128 + d], t2 = tot[256 + d], t3 = tot[384 + d];
            const float off = (qr > 0 ? t0 : 0.f) + (qr > 1 ? t1 : 0.f) + (qr > 2 ? t2 : 0.f);
            const float Bmid = t0 + t1, blast = Bmid + t2 + t3;
            unsigned ksp[8];
            {
                const f32x4 bm4 = *(const LAS f32x4*)(tot + 16 * w + 4 * g) + *(const LAS f32x4*)(tot + 128 + 16 * w + 4 * g);
                const f32x4 bl4 = bm4 + *(const LAS f32x4*)(tot + 256 + 16 * w + 4 * g) + *(const LAS f32x4*)(tot + 384 + 16 * w + 4 * g);
                el4 = (f32x4){__expf(bl4[0]), __expf(bl4[1]), __expf(bl4[2]), __expf(bl4[3])};
                if (PASS == 2) {
                    const f32x4 eb = (f32x4){__expf(bm4[0]), __expf(bm4[1]), __expf(bm4[2]), __expf(bm4[3])};
#pragma unroll
                    for (int et = 0; et < 8; ++et) { const f32x4 v = S[et] * eb;
                        *(LAS v2u*)(L + O_SPT + (16 * et + c16) * RS1 + (16 * w + 4 * g) * 2) = (v2u){pk2(v[0], v[1]), pk2(v[2], v[3])}; }
                }
            }
            float fv[16];
#pragma unroll
            for (int i = 0; i < 16; ++i) fv[i] = __expf(gv[i]);
            if (PASS == 2) {
                float E = __expf(fminf(off + cs[0] - Bmid, 80.f));
#pragma unroll
                for (int i = 0; i < 16; ++i) { if (i > 0) E *= fv[i];
                    *(LAS unsigned short*)(L + O_QA + (16 * qr + i) * RS1 + d * 2) = (unsigned short)f2bf(bf2f(qc[i]) * E); }
            }
            {
                float D = (PASS == 2) ? __expf(fminf(Bmid - (off + cs[15]), 80.f)) : 0.f, S = __expf(blast - (off + cs[15])), ksn = 0.f;
#pragma unroll
                for (int i = 15; i >= 0; --i) { const float k = 1.0f - fv[i]; const float ks = k * S;
                    if (PASS == 2) { *(LAS unsigned short*)(L + O_KA + (16 * qr + i) * RS1 + d * 2) = (unsigned short)f2bf(k * D); D *= fv[i]; }
                    S *= fv[i];
                    if (i & 1) ksn = ks; else ksp[i >> 1] = pk2(ks, ksn); }
            }
            *(LAS v4u*)(L + O_KST + d * RS2 + qr * 32) = (v4u){ksp[0], ksp[1], ksp[2], ksp[3]};
            *(LAS v4u*)(L + O_KST + d * RS2 + qr * 32 + 16) = (v4u){ksp[4], ksp[5], ksp[6], ksp[7]};
            if (qr == 0) dsum += blast;
        }
        HG_SYNC();
        f32x4 oT[4];
        if (PASS == 2) {
            bf16x8 qf[4];
#pragma unroll
            for (int ks = 0; ks < 4; ++ks) qf[ks] = lds_b128(L + O_QA + (16 * tt + c16) * RS1 + (32 * ks + 8 * g) * 2);
            f32x4 x[4];
#pragma unroll
            for (int st = 0; st < 4; ++st) {
                x[st] = (f32x4){0.f, 0.f, 0.f, 0.f};
                if (st <= tt) {
#pragma unroll
                    for (int ks = 0; ks < 4; ++ks) x[st] = __builtin_amdgcn_mfma_f32_16x16x32_bf16(lds_b128(L + O_KA + (16 * st + c16) * RS1 + (32 * ks + 8 * g) * 2), qf[ks], x[st], 0, 0, 0);
                    if (st == tt) {
#pragma unroll
                        for (int i = 0; i < 4; ++i) if (4 * g + i > c16) x[st][i] = 0.f;
                    }
                }
            }
            bf16x8 xb[2];
#pragma unroll
            for (int p = 0; p < 2; ++p) { const v4u t = (v4u){pk2(x[2 * p][0], x[2 * p][1]), pk2(x[2 * p][2], x[2 * p][3]), pk2(x[2 * p + 1][0], x[2 * p + 1][1]), pk2(x[2 * p + 1][2], x[2 * p + 1][3])};
                xb[p] = __builtin_bit_cast(bf16x8, t); }
#pragma unroll
            for (int e4 = 0; e4 < 4; ++e4) {
                const int et = 4 * eh + e4; f32x4 acc = (f32x4){0.f, 0.f, 0.f, 0.f};
#pragma unroll
                for (int p = 0; p < 2; ++p) {
                    if (p == 0 || tt >= 2) {
                        const v2u a0 = *(const LAS v2u*)(L + O_VT + (16 * et + c16) * RS2 + (32 * p + 4 * g) * 2);
                        const v2u a1 = *(const LAS v2u*)(L + O_VT + (16 * et + c16) * RS2 + (32 * p + 16 + 4 * g) * 2);
                        const v4u a = (v4u){a0.x, a0.y, a1.x, a1.y};
                        acc = __builtin_amdgcn_mfma_f32_16x16x32_bf16(__builtin_bit_cast(bf16x8, a), xb[p], acc, 0, 0, 0);
                    }
                }
#pragma unroll
                for (int ks = 0; ks < 4; ++ks) acc = __builtin_amdgcn_mfma_f32_16x16x32_bf16(lds_b128(L + O_SPT + (16 * et + c16) * RS1 + (32 * ks + 8 * g) * 2), qf[ks], acc, 0, 0, 0);
                oT[e4] = acc;
            }
        }
        {
            const f32x4 el = el4;
#pragma unroll
            for (int et = 0; et < 8; ++et) S[et] = S[et] * el;
#pragma unroll
            for (int ks = 0; ks < 2; ++ks) { const bf16x8 a = lds_b128(L + O_KST + (16 * w + c16) * RS2 + (32 * ks + 8 * g) * 2);
#pragma unroll
                for (int et = 0; et < 8; ++et) S[et] = __builtin_amdgcn_mfma_f32_16x16x32_bf16(a, lds_b128(L + O_VT + (16 * et + c16) * RS2 + (32 * ks + 8 * g) * 2), S[et], 0, 0, 0); }
        }
        if (PASS == 2) {
            float ss = 0.f;
#pragma unroll
            for (int e4 = 0; e4 < 4; ++e4) ss += (oT[e4][0] * oT[e4][0] + oT[e4][1] * oT[e4][1]) + (oT[e4][2] * oT[e4][2] + oT[e4][3] * oT[e4][3]);
            ss += __shfl_xor(ss, 16); ss += __shfl_xor(ss, 32);
            if (g == 0) red[(16 * tt + c16) * 2 + eh] = ss;
            HG_SYNC();
            const float rstd = 1.0f / sqrtf((red[(16 * tt + c16) * 2] + red[(16 * tt + c16) * 2 + 1]) * (1.f / 128.f) + EPS);
            const size_t orow = (R0 + 16 * tt + c16) * 1024 + h * 128;
#pragma unroll
            for (int e4 = 0; e4 < 4; ++e4) { const int e0 = 16 * (4 * eh + e4) + 4 * g;
                const f32x4 gn = gnr[e4]; const v2u sg = sgc[e4];
                const f32x4 o = oT[e4] * rstd * gn;
                *(v2u*)(OAp + orow + e0) = (v2u){pk2(o[0] * bflo(sg.x), o[1] * bfhi(sg.x)), pk2(o[2] * bflo(sg.y), o[3] * bfhi(sg.y))}; }
        } else {
            HG_SYNC();
        }
    }
    if (PASS == 1) {
        float* up = Ubuf + ((size_t)(bh * HG_NSEG + seg) * 8 + w) * 2048 + lane * 4;
#pragma unroll
        for (int et = 0; et < 8; ++et) *(f32x4*)(up + et * 256) = S[et];
        if (qr == 0) Dlg[(size_t)(bh * HG_NSEG + seg) * 128 + d] = dsum;
    }
    HG_SYNC();
}
__device__ __forceinline__ void hgrn_prefix(const Ctx& F) {
    float* Ubuf = F.out; const float* Dlg = F.out + HG_DLG_OFF;
    const int tid = F_TID;
    for (int item = F.bid; item < 16 * 16; item += F.G) {
        const int bh = item >> 4, p = (item & 15) * 1024 + tid * 2, w = p >> 11;
        const int dch = 16 * w + 4 * ((p >> 6) & 3) + (p & 3);
        pg8::f32x2_t u[HG_NSEG], dl[HG_NSEG];
#pragma unroll
        for (int j = 0; j < HG_NSEG; ++j) { u[j] = *(const pg8::f32x2_t*)(Ubuf + (size_t)(bh * HG_NSEG + j) * 16384 + p); dl[j] = *(const pg8::f32x2_t*)(Dlg + (size_t)(bh * HG_NSEG + j) * 128 + dch); }
        pg8::f32x2_t st = (pg8::f32x2_t){0.f, 0.f};
#pragma unroll
        for (int j = 0; j < HG_NSEG; ++j) {
            *(pg8::f32x2_t*)(Ubuf + (size_t)(bh * HG_NSEG + j) * 16384 + p) = st;
            st = (pg8::f32x2_t){st[0] * __expf(dl[j][0]) + u[j][0], st[1] * __expf(dl[j][1]) + u[j][1]};
        }
    }
}
#ifndef DSA_FAST
#define DSA_FAST 1
#endif
#if DSA_FAST
namespace dq {
#ifndef SEL_MINSPAN
#define SEL_MINSPAN 8192
#endif
#ifndef SEL_INTERP
#define SEL_INTERP 0
#endif
#ifndef KEEP_MAX
#define KEEP_MAX 272
#endif
#ifndef PRUNE_MIN
#define PRUNE_MIN 256
#endif
constexpr int CAP = 512, PRUNE_AT = CAP - 64;
constexpr int O_BUF = 0;
constexpr int O_KT = 131072;
constexpr int O_TAU = 155648, O_CNT = O_TAU + 256, O_HIST = O_CNT + 256;
constexpr int O_BKT = O_HIST + 4096, O_RB = O_BKT + 512, O_FLAG = O_RB + 1024, O_END = O_FLAG + 16;
static_assert(O_END <= MISC_OFF, "dsa lds");
constexpr int O_Q = O_KT, O_LG = O_KT + 2048, O_SEL = O_LG + 8192;
typedef float f32x16 __attribute__((ext_vector_type(16)));
}
__device__ __forceinline__ unsigned wave_incl_scan(unsigned v) {
    v += (unsigned)__builtin_amdgcn_update_dpp(0, (int)v, 0x111, 0xf, 0xf, false);
    v += (unsigned)__builtin_amdgcn_update_dpp(0, (int)v, 0x112, 0xf, 0xf, false);
    v += (unsigned)__builtin_amdgcn_update_dpp(0, (int)v, 0x114, 0xf, 0xf, false);
    v += (unsigned)__builtin_amdgcn_update_dpp(0, (int)v, 0x118, 0xf, 0xf, false);
    v += (unsigned)__builtin_amdgcn_update_dpp(0, (int)v, 0x142, 0xa, 0xf, false);
    v += (unsigned)__builtin_amdgcn_update_dpp(0, (int)v, 0x143, 0xc, 0xf, false);
    return v;
}
__device__ __forceinline__ unsigned wave_red_and(unsigned v) {
    v &= (unsigned)__builtin_amdgcn_update_dpp(-1, (int)v, 0x111, 0xf, 0xf, false); v &= (unsigned)__builtin_amdgcn_update_dpp(-1, (int)v, 0x112, 0xf, 0xf, false);
    v &= (unsigned)__builtin_amdgcn_update_dpp(-1, (int)v, 0x114, 0xf, 0xf, false); v &= (unsigned)__builtin_amdgcn_update_dpp(-1, (int)v, 0x118, 0xf, 0xf, false);
    v &= (unsigned)__builtin_amdgcn_update_dpp(-1, (int)v, 0x142, 0xa, 0xf, false); v &= (unsigned)__builtin_amdgcn_update_dpp(-1, (int)v, 0x143, 0xc, 0xf, false);
    return (unsigned)__builtin_amdgcn_readlane((int)v, 63);
}
__device__ __forceinline__ unsigned wave_red_or(unsigned v) {
    v |= (unsigned)__builtin_amdgcn_update_dpp(0, (int)v, 0x111, 0xf, 0xf, false); v |= (unsigned)__builtin_amdgcn_update_dpp(0, (int)v, 0x112, 0xf, 0xf, false);
    v |= (unsigned)__builtin_amdgcn_update_dpp(0, (int)v, 0x114, 0xf, 0xf, false); v |= (unsigned)__builtin_amdgcn_update_dpp(0, (int)v, 0x118, 0xf, 0xf, false);
    v |= (unsigned)__builtin_amdgcn_update_dpp(0, (int)v, 0x142, 0xa, 0xf, false); v |= (unsigned)__builtin_amdgcn_update_dpp(0, (int)v, 0x143, 0xc, 0xf, false);
    return (unsigned)__builtin_amdgcn_readlane((int)v, 63);
}
template <bool EXACT>
__device__ __forceinline__ unsigned wave_select256(LAS unsigned* buf, int n, unsigned lo0, int lane, int* kept) {
    const v4u ka = *(const LAS v4u*)(buf + lane * 8), kb = *(const LAS v4u*)(buf + lane * 8 + 4);
    unsigned k[8] = {ka.x, ka.y, ka.z, ka.w, kb.x, kb.y, kb.z, kb.w};
    unsigned vo = 0u;
#pragma unroll
    for (int i = 0; i < 8; ++i) { if (lane * 8 + i >= n) k[i] = 0u; vo |= k[i]; }
    const unsigned allor = wave_red_or(vo);
    unsigned lo = lo0 + 1u, hi = (allor >= 0xFFFFFFFEu ? 0xFFFFFFFEu : allor) + 1u;
    unsigned flo = (unsigned)n, fhi = 0u;
    constexpr unsigned TGT = EXACT ? 256u : (unsigned)((256 + KEEP_MAX) / 2);
#pragma unroll 1
    for (unsigned it = 0u; hi - lo > (EXACT ? 1u : (unsigned)SEL_MINSPAN); ++it) {
        if (flo <= (EXACT ? 256u : (unsigned)KEEP_MAX)) break;
        const unsigned span = hi - lo;
        unsigned mid = lo + (span >> 1);
#if SEL_INTERP
        if (!(it & 1u)) {
            const float fr = (float)(flo - TGT) * __builtin_amdgcn_rcpf((float)(flo - fhi));
            unsigned d = (unsigned)((float)span * fr); d = d < 1u ? 1u : (d > span - 1u ? span - 1u : d);
            mid = __builtin_amdgcn_readfirstlane(lo + d);
        }
#endif
        unsigned c = 0u;
#pragma unroll
        for (int i = 0; i < 8; ++i) c += (unsigned)__builtin_popcountll(__ballot(k[i] >= mid));
        if (c >= 256u) { lo = mid; flo = c; } else { hi = mid; fhi = c; }
    }
    if (!EXACT && flo > 448u) {
#pragma unroll 1
        while (hi - lo > 1u && flo > (unsigned)KEEP_MAX) {
            const unsigned mid = lo + ((hi - lo) >> 1);
            unsigned c = 0u;
#pragma unroll
            for (int i = 0; i < 8; ++i) c += (unsigned)__builtin_popcountll(__ballot(k[i] >= mid));
            if (c >= 256u) { lo = mid; flo = c; } else { hi = mid; fhi = c; }
        }
    }
    int base = 0;
#pragma unroll
    for (int i = 0; i < 8; ++i) { const bool keep = k[i] >= lo; const unsigned long long bal = __ballot(keep);
        const int pos = base + (int)__builtin_amdgcn_mbcnt_hi((unsigned)(bal >> 32), __builtin_amdgcn_mbcnt_lo((unsigned)bal, 0u));
        if (keep) buf[pos] = k[i];
        base += __builtin_popcountll(bal); }
    *kept = base;
    return lo;
}
__device__ __forceinline__ void dsa_tables(const Ctx& F) {
    LAS int* bkt = (LAS int*)(F.lds + dq::O_BKT); LAS float* rb = (LAS float*)(F.lds + dq::O_RB);
    if (F_TID < 128) { const int dd = F_TID; int bk = dd;
        if (dd >= 16) { const int lg = 16 + (int)(logf((float)dd / 16.0f) / 2.0794415416798357f * 16.0f); bk = lg < 31 ? lg : 31; }
        bkt[dd] = bk; }
    if (F_TID < 256) rb[F_TID] = F.in[11][F_TID];
    __syncthreads();
}
__device__ __forceinline__ unsigned pack_key(float v, int s) {
    unsigned u = __builtin_bit_cast(unsigned, v); u = (u == 0x80000000u) ? 0u : u;
    const unsigned m = (u >> 31) ? 0xFFFFFFFFu : 0x80000000u;
    return ((u ^ m) & 0xFFFFE000u) | (unsigned)(8191 - s);
}
__device__ __forceinline__ unsigned pack_key_nz(float v, int s) {
    const unsigned u = __builtin_bit_cast(unsigned, v); const unsigned m = (unsigned)((int)u >> 31) | 0x80000000u;
    return ((u ^ m) & 0xFFFFE000u) | (unsigned)(8191 - s);
}
__device__ __forceinline__ void stage_keys(const unsigned short* IKN, int b, int T, LAS unsigned char* dst, int wave, int lane) {
    const int P = wave * 64 + lane, sub = P >> 8, p = P & 255, pair = p >> 4, s = (p & 15) ^ (pair & 7), n = 2 * pair + (s >> 3), c = s & 7;
    const unsigned short* src = IKN + ((size_t)b * SEQ + (size_t)T * 64 + sub * 32 + n) * 64 + c * 8;
    __builtin_amdgcn_global_load_lds((const unsigned*)src, (LAS unsigned*)(dst + wave * 1024), 16, 0, 0);
}
__device__ __forceinline__ void attn_row_block(const Ctx& F, int b, int t, const LAS unsigned* selk, int nsel) {
    using namespace dq;
    const int tid = F_TID, lane = F_LANE, wave = F.wave;
    LAS unsigned char* L = F.lds;
    LAS float* qs = (LAS float*)(L + O_Q); LAS float* lg = (LAS float*)(L + O_LG); LAS int* sel = (LAS int*)(L + O_SEL);
    LAS int* bkt = (LAS int*)(L + O_BKT); LAS float* rb = (LAS float*)(L + O_RB);
    const size_t row = (size_t)b * SEQ + t;
    const bf16* AQ = (const bf16*)(F.ws + WS_AQ); const bf16* KV = (const bf16*)(F.ws + WS_KV); bf16* OB = (bf16*)(F.ws + WS_OB);
    if (tid < nsel) sel[tid] = 8191 - (int)(selk[tid] & 8191u);
    { const int hd = tid >> 6, dd = tid & 63; qs[((hd >> 2) * 64 + dd) * 4 + (hd & 3)] = bf2f(AQ[row * 512 + tid]); }
    __syncthreads();
    {
        const int j = tid & 255, grp = tid >> 8;
        if (j < nsel) {
            const int sidx = sel[j]; const bf16* kp = KV + ((size_t)b * SEQ + sidx) * 256 + grp * 64;
            f32x4 a = (f32x4){0.f, 0.f, 0.f, 0.f};
#pragma unroll 1
            for (int c = 0; c < 8; ++c) { const v4u kk = *(const v4u*)(kp + 8 * c);
                const float kf[8] = {bflo(kk.x), bfhi(kk.x), bflo(kk.y), bfhi(kk.y), bflo(kk.z), bfhi(kk.z), bflo(kk.w), bfhi(kk.w)};
#pragma unroll
                for (int e = 0; e < 8; ++e) a += *(const LAS f32x4*)(qs + (grp * 64 + 8 * c + e) * 4) * kf[e]; }
            const int dist = t - sidx; const int bk = dist < 128 ? bkt[dist] : 31;
#pragma unroll
            for (int r = 0; r < 4; ++r) lg[(grp * 4 + r) * 256 + j] = a[r] + rb[bk * 8 + grp * 4 + r];
        }
    }
    __syncthreads();
    {
        float v[4]; float mx = -3.0e38f;
#pragma unroll
        for (int i = 0; i < 4; ++i) { const int j = lane + 64 * i; v[i] = j < nsel ? lg[wave * 256 + j] : -3.0e38f; mx = fmaxf(mx, v[i]); }
#pragma unroll
        for (int o = 1; o < 64; o <<= 1) mx = fmaxf(mx, __shfl_xor(mx, o));
        float sm = 0.f;
#pragma unroll
        for (int i = 0; i < 4; ++i) { const int j = lane + 64 * i; v[i] = j < nsel ? __expf(v[i] - mx) : 0.f; sm += v[i]; }
        sm = wave_sum(sm); const float inv = 1.0f / sm;
#pragma unroll
        for (int i = 0; i < 4; ++i) { const int j = lane + 64 * i; lg[wave * 256 + j] = v[i] * inv; }
    }
    __syncthreads();
    {
        const int e = tid & 127, grp = e >> 6, r = tid >> 7, head = grp * 4 + r; float acc = 0.f;
        const bf16* vp = KV + (size_t)b * SEQ * 256 + 128 + e;
        for (int j = 0; j < nsel; ++j) acc += lg[head * 256 + j] * bf2f(vp[(size_t)sel[j] * 256]);
        OB[row * 512 + head * 64 + (e & 63)] = (bf16)f2bf(acc);
    }
    __syncthreads();
}
typedef short v4i16_t __attribute__((ext_vector_type(4)));
typedef float f32x2v __attribute__((ext_vector_type(2)));
#ifndef ATT_FULL_PATH
#define ATT_FULL_PATH 1
#endif
#ifndef PV_FP8
#define PV_FP8 1
#endif
typedef int v2i32_t __attribute__((ext_vector_type(2)));
#ifndef PV_RD
#define PV_RD 4
#endif
#ifndef PV_EARLY
#define PV_EARLY 0
#endif
#ifndef ATT_REP
#define ATT_REP 1
#endif
#ifndef ATT_NP
#define ATT_NP 8
#endif
template <bool FULL>
__device__ __forceinline__ void attn_row_wave(const Ctx& F, int b, int t, const LAS unsigned* kb, int nsel_, LAS unsigned char* vimg, int lane_in, bool second = false) {
    const int nsel = FULL ? 256 : nsel_;
    int lane = lane_in; asm volatile("" : "+v"(lane));
    const int g4o = 4 * (lane >> 4);
    using namespace dq;
    const int c16 = lane & 15, g = lane >> 4;
    const LAS int* bkt = (const LAS int*)(F.lds + O_BKT); const LAS float* rb = (const LAS float*)(F.lds + O_RB);
    const size_t row = (size_t)b * SEQ + t;
    const bf16* AQ = (const bf16*)(F.ws + WS_AQ); const unsigned char* KV = (const unsigned char*)(F.ws + WS_KV) + (size_t)b * SEQ * 256; bf16* OB = (bf16*)((unsigned char*)F.out + OAB_OFF) + 512;
    long qf[4];
#pragma unroll
    for (int ks = 0; ks < 4; ++ks) { const v4u z = *(const v4u*)(AQ + row * 512 + (c16 & 7) * 64 + 32 * (ks & 1) + 8 * g);
        const bool ok = c16 < 8 && (c16 >> 2) == (ks >> 1);
        int w0 = __builtin_amdgcn_cvt_pk_fp8_f32(bflo(z.x) * 8.f, bfhi(z.x) * 8.f, 0, false); w0 = __builtin_amdgcn_cvt_pk_fp8_f32(bflo(z.y) * 8.f, bfhi(z.y) * 8.f, w0, true);
        int w1 = __builtin_amdgcn_cvt_pk_fp8_f32(bflo(z.z) * 8.f, bfhi(z.z) * 8.f, 0, false); w1 = __builtin_amdgcn_cvt_pk_fp8_f32(bflo(z.w) * 8.f, bfhi(z.w) * 8.f, w1, true);
        w0 = ok ? w0 : 0; w1 = ok ? w1 : 0;
        qf[ks] = (long)(((unsigned long long)(unsigned)w1 << 32) | (unsigned long long)(unsigned)w0); }
    bf16x8 rbf;
    { const int hc = c16 & 7; unsigned wv_[4];
#pragma unroll
      for (int q = 0; q < 4; ++q) { const float a = rb[(8 * g + 2 * q) * 8 + hc] * 8.f, bq = rb[(8 * g + 2 * q + 1) * 8 + hc] * 8.f; const unsigned pkd = pk2(a, bq); wv_[q] = c16 < 8 ? pkd : 0u; }
      rbf = __builtin_bit_cast(bf16x8, (v4u){wv_[0], wv_[1], wv_[2], wv_[3]}); }
    const float b31 = c16 < 8 ? rb[31 * 8 + (c16 & 7)] * 8.f : 0.f;
    f32x4 lg[16];
    {
        v4u kq[16][2]; int dsv[16];
#define QK_LD(KT) do { const int slot = 16 * (KT) + c16; const int idx0 = 8191 - (int)(kb[slot] & 8191u); const int idx = (FULL || slot < nsel) ? idx0 : 0; \
            const unsigned koff = (unsigned)(idx * 256 + 32 * g); kq[KT][0] = *(const v4u*)(KV + koff); kq[KT][1] = *(const v4u*)(KV + koff + 16); \
            dsv[KT] = t - idx; } while (0)
#define QK_MM(KT) do { const bool anynear = __builtin_amdgcn_ballot_w64(dsv[KT] < 128) != 0ull; const float ci = anynear ? 0.f : b31; f32x4 acc = (f32x4){ci, ci, ci, ci}; \
            acc = __builtin_amdgcn_mfma_f32_16x16x32_fp8_fp8((long)(((unsigned long long)kq[KT][0].y << 32) | kq[KT][0].x), qf[0], acc, 0, 0, 0); \
            acc = __builtin_amdgcn_mfma_f32_16x16x32_fp8_fp8((long)(((unsigned long long)kq[KT][0].w << 32) | kq[KT][0].z), qf[1], acc, 0, 0, 0); \
            acc = __builtin_amdgcn_mfma_f32_16x16x32_fp8_fp8((long)(((unsigned long long)kq[KT][1].y << 32) | kq[KT][1].x), qf[2], acc, 0, 0, 0); \
            acc = __builtin_amdgcn_mfma_f32_16x16x32_fp8_fp8((long)(((unsigned long long)kq[KT][1].w << 32) | kq[KT][1].z), qf[3], acc, 0, 0, 0); \
            if (anynear) { const int dist = dsv[KT]; const int dcl = dist < 0 ? 0 : (dist > 127 ? 127 : dist); \
              const int dd = bkt[dcl] - 8 * g; const unsigned one = (dd & 1) ? 0x3F800000u : 0x00003F80u; const int wq = ((unsigned)dd < 8u) ? (dd >> 1) : -1; \
              const v4u oh = (v4u){wq == 0 ? one : 0u, wq == 1 ? one : 0u, wq == 2 ? one : 0u, wq == 3 ? one : 0u}; \
              acc = __builtin_amdgcn_mfma_f32_16x16x32_bf16(__builtin_bit_cast(bf16x8, oh), rbf, acc, 0, 0, 0); }     \
            lg[KT] = acc; } while (0)
#pragma unroll
        for (int kt = 0; kt < 8; ++kt) QK_LD(kt);
        __builtin_amdgcn_sched_barrier(0);
#pragma unroll
        for (int kt = 0; kt < 4; ++kt) QK_MM(kt);
        __builtin_amdgcn_sched_barrier(0);
#pragma unroll
        for (int kt = 8; kt < 16; ++kt) { if (kt == 12) { QK_MM(4); QK_MM(5); QK_MM(6); QK_MM(7); __builtin_amdgcn_sched_barrier(0); } QK_LD(kt); }
        __builtin_amdgcn_sched_barrier(0);
#pragma unroll
        for (int kt = 8; kt < 16; ++kt) QK_MM(kt);
        asm volatile("" ::: "memory");
#undef QK_LD
#undef QK_MM
    }
#define PV_LOAD(dst, P) do { _Pragma("unroll") for (int it = 0; it < 4; ++it) { const int kk = it * 8 + (lane >> 3); const int slot = 32 * (P) + kk; \
        const int idx0 = 8191 - (int)(kb[slot & 255] & 8191u); const int idx = (FULL || slot < nsel) ? idx0 : 0; \
        dst[it] = *(const v4u*)(KV + (unsigned)(idx * 256 + 128 + (lane & 7) * 16)); } } while (0)
    v4u vr[PV_RD][4];
#define PV_INIT(P) do { if ((P) < PV_RD - 1 && (P) < 8) PV_LOAD(vr[(P) % PV_RD], P); } while (0)
#if PV_EARLY
    PV_INIT(0); PV_INIT(1); PV_INIT(2); PV_INIT(3); PV_INIT(4); PV_INIT(5); PV_INIT(6); PV_INIT(7);
    __builtin_amdgcn_sched_barrier(0);
#endif
    float mx = -3.0e38f;
#pragma unroll
    for (int kt = 0; kt < 16; ++kt)
#pragma unroll
        for (int i = 0; i < 4; ++i) { const int slot = 16 * kt + g4o + i; const float v = (FULL || slot < nsel) ? lg[kt][i] : -3.0e38f; lg[kt][i] = v; mx = fmaxf(mx, v); }
    mx = fmaxf(mx, __shfl_xor(mx, 16)); mx = fmaxf(mx, __shfl_xor(mx, 32));
    float sm = 0.f;
    constexpr float SC2 = 0.125f * 1.4426950408889634f; const float nmx = -mx * SC2 + (PV_FP8 ? 7.0f : 0.0f);
#pragma unroll
    for (int kt = 0; kt < 16; ++kt)
#pragma unroll
        for (int i = 0; i < 4; ++i) { const int slot = 16 * kt + g4o + i; const float e = (FULL || slot < nsel) ? __builtin_amdgcn_exp2f(__builtin_fmaf(lg[kt][i], SC2, nmx)) : 0.f; lg[kt][i] = e; sm += e; }
    sm += __shfl_xor(sm, 16); sm += __shfl_xor(sm, 32);
    const float inv = 1.0f / sm;
#if PV_FP8
    long pbs[8];
#pragma unroll
    for (int p = 0; p < 8; ++p) { const f32x4 p0 = lg[2 * p], p1 = lg[2 * p + 1];
        int w0 = __builtin_amdgcn_cvt_pk_fp8_f32(p0[0], p0[1], 0, false); w0 = __builtin_amdgcn_cvt_pk_fp8_f32(p0[2], p0[3], w0, true);
        int w1 = __builtin_amdgcn_cvt_pk_fp8_f32(p1[0], p1[1], 0, false); w1 = __builtin_amdgcn_cvt_pk_fp8_f32(p1[2], p1[3], w1, true);
        pbs[p] = (long)(((unsigned long long)(unsigned)w1 << 32) | (unsigned long long)(unsigned)w0); }
    f32x4 oT[8];
#pragma unroll
    for (int et = 0; et < 8; ++et) oT[et] = (f32x4){0.f, 0.f, 0.f, 0.f};
#define PV_MMA(P) do { const long pf = pbs[P]; \
        _Pragma("unroll") for (int et = 0; et < 8; ++et) { const int rq = c16 >> 1; \
            const v2i32_t a = __builtin_amdgcn_ds_read_tr8_b64_v2i32((LAS v2i32_t*)(vimg + (4 * ((P) & 1) + g) * 2048 + rq * 128 + ((et ^ rq ^ (g & 1)) * 16) + (c16 & 1) * 8)); \
            oT[et] = __builtin_amdgcn_mfma_f32_16x16x32_fp8_fp8((long)(((unsigned long long)(unsigned)a[1] << 32) | (unsigned long long)(unsigned)a[0]), pf, oT[et], 0, 0, 0); } } while (0)
    {
#define PV_WRITE(src, P) do { _Pragma("unroll") for (int it = 0; it < 4; ++it) { const int kk = it * 8 + (lane >> 3); const int R = 8 * ((kk & 15) >> 2) + (kk & 3) + 4 * (kk >> 4); \
            const int pos = (lane & 7) ^ (R & 7) ^ ((R >> 3) & 1); \
            *(LAS v4u*)(vimg + (4 * ((P) & 1) + (R >> 3)) * 2048 + (R & 7) * 128 + pos * 16) = src[it]; } } while (0)
#else
    v4u pbs[8];
#pragma unroll
    for (int p = 0; p < 8; ++p) { const f32x4 p0 = lg[2 * p], p1 = lg[2 * p + 1];
        pbs[p] = (v4u){pk2(p0[0], p0[1]), pk2(p0[2], p0[3]), pk2(p1[0], p1[1]), pk2(p1[2], p1[3])}; }
    f32x4 oT[8];
#pragma unroll
    for (int et = 0; et < 8; ++et) oT[et] = (f32x4){0.f, 0.f, 0.f, 0.f};
    const int q4 = c16 >> 2, pp = c16 & 3;
#define PV_MMA(P) do { const bf16x8 pf = __builtin_bit_cast(bf16x8, pbs[P]); \
        asm volatile("s_waitcnt lgkmcnt(0)" ::: "memory"); \
        _Pragma("unroll") for (int et = 0; et < 8; ++et) { const int ch = 2 * et + (pp >> 1); const int kk0 = 4 * g + q4, kk1 = 16 + 4 * g + q4; \
            const int sw0 = ((kk0 & 3) << 1) | (((kk0 >> 2) & 1) << 3), sw1 = ((kk1 & 3) << 1) | (((kk1 >> 2) & 1) << 3); \
            const v4i16_t a0 = __builtin_amdgcn_ds_read_tr16_b64_v4i16((LAS v4i16_t*)(vimg + (kk0 >> 2) * 2048 + (kk0 & 3) * 256 + ((ch ^ sw0) * 16) + (pp & 1) * 8)); \
            const v4i16_t a1 = __builtin_amdgcn_ds_read_tr16_b64_v4i16((LAS v4i16_t*)(vimg + (kk1 >> 2) * 2048 + (kk1 & 3) * 256 + ((ch ^ sw1) * 16) + (pp & 1) * 8)); \
            const bf16x8 af = (bf16x8){a0[0], a0[1], a0[2], a0[3], a1[0], a1[1], a1[2], a1[3]}; \
            oT[et] = __builtin_amdgcn_mfma_f32_16x16x32_bf16(af, pf, oT[et], 0, 0, 0); } \
        asm volatile("s_waitcnt lgkmcnt(0)" ::: "memory"); } while (0)
    {
#define PV_WRITE(src, P) do { _Pragma("unroll") for (int it = 0; it < 4; ++it) { const int kk = it * 8 + (lane >> 3); const int sw = ((kk & 3) << 1) | (((kk >> 2) & 1) << 3); const int ch = lane & 7; \
            const unsigned wsrc[4] = {src[it].x, src[it].y, src[it].z, src[it].w}; unsigned o[8]; \
            _Pragma("unroll") for (int q = 0; q < 4; ++q) { const f32x2v lo2 = __builtin_amdgcn_cvt_pk_f32_fp8((int)wsrc[q], false), hi2 = __builtin_amdgcn_cvt_pk_f32_fp8((int)wsrc[q], true); \
                o[2 * q] = pk2(lo2[0], lo2[1]); o[2 * q + 1] = pk2(hi2[0], hi2[1]); } \
            LAS unsigned char* rowp = vimg + (kk >> 2) * 2048 + (kk & 3) * 256; \
            *(LAS v4u*)(rowp + (((2 * ch) ^ sw) * 16)) = (v4u){o[0], o[1], o[2], o[3]}; \
            *(LAS v4u*)(rowp + (((2 * ch + 1) ^ sw) * 16)) = (v4u){o[4], o[5], o[6], o[7]}; } } while (0)
#endif
#if !PV_EARLY
        PV_INIT(0); PV_INIT(1); PV_INIT(2); PV_INIT(3); PV_INIT(4); PV_INIT(5); PV_INIT(6); PV_INIT(7);
        __builtin_amdgcn_sched_barrier(0);
#endif
#undef PV_INIT
#define PV_ONE(P) do { if (FULL || 32 * (P) < nsel) { PV_WRITE(vr[(P) % PV_RD], P); asm volatile("" ::: "memory"); if ((P) + PV_RD - 1 < 8) PV_LOAD(vr[((P) + PV_RD - 1) % PV_RD], (P) + PV_RD - 1); PV_MMA(P); } } while (0)
        PV_ONE(0); PV_ONE(1); PV_ONE(2); PV_ONE(3); PV_ONE(4); PV_ONE(5); PV_ONE(6); PV_ONE(7);
#undef PV_ONE
#undef PV_WRITE
    }
#undef PV_LOAD
#undef PV_MMA
#ifdef ATT_SELFCHECK
#define SC_STORE(O) do { v2u nv = (v2u){pk2((O)[0], (O)[1]), pk2((O)[2], (O)[3])}; v2u* dst = (v2u*)(OB + row * 1024 + c16 * 64 + 16 * k + 4 * g); \
        if (second) { const v2u ov = *(volatile v2u*)dst; if (ov.x != nv.x || ov.y != nv.y) nv = (v2u){0x7fc07fc0u, 0x7fc07fc0u}; } *dst = nv; } while (0)
    if (c16 < 4) {
#pragma unroll
        for (int k = 0; k < 4; ++k) { const f32x4 o = oT[k] * inv; SC_STORE(o); }
    } else if (c16 < 8) {
#pragma unroll
        for (int k = 0; k < 4; ++k) { const f32x4 o = oT[4 + k] * inv; SC_STORE(o); }
    }
#else
    if (c16 < 4) {
#pragma unroll
        for (int k = 0; k < 4; ++k) { const f32x4 o = oT[k] * inv;
            *(v2u*)(OB + row * 1024 + c16 * 64 + 16 * k + 4 * g) = (v2u){pk2(o[0], o[1]), pk2(o[2], o[3])}; }
    } else if (c16 < 8) {
#pragma unroll
        for (int k = 0; k < 4; ++k) { const f32x4 o = oT[4 + k] * inv;
            *(v2u*)(OB + row * 1024 + c16 * 64 + 16 * k + 4 * g) = (v2u){pk2(o[0], o[1]), pk2(o[2], o[3])}; }
    }
#endif
}
#ifndef SCAN_REAL
#define SCAN_REAL 0
#endif
#ifndef SCAN_REP
#define SCAN_REP 1
#endif
__device__ __forceinline__ void dsa_unit(const Ctx& F, int b, int j) {
    using namespace dq;
    int lane_ = F_LANE; asm volatile("" : "+v"(lane_));
    const int lane = lane_, w = F.wave, n = lane & 31, H = lane >> 5;
    LAS unsigned char* L = F.lds;
    LAS unsigned* tau = (LAS unsigned*)(L + O_TAU); LAS unsigned* cnt = (LAS unsigned*)(L + O_CNT); LAS unsigned* hist = (LAS unsigned*)(L + O_HIST + w * 512);
    const unsigned short* IQ = (const unsigned short*)(F.ws + WS_IQ); const unsigned short* IKN = (const unsigned short*)(F.ws + WS_IKN);
    const float* IKW = (const float*)(F.ws + WS_IKW);
    const int t0 = 64 * j; const size_t rowg = (size_t)b * SEQ + t0 + 8 * w;
    LAS unsigned* pflag = (LAS unsigned*)(L + O_FLAG);
    if (w == 0) { tau[lane] = 0u; cnt[lane] = 0u; if (lane < 3) pflag[lane] = 0u; }
    if (SCAN_REP == 1) { stage_keys(IKN, b, 0, L + O_KT, w, lane); stage_keys(IKN, b, j < 1 ? j : 1, L + O_KT + 8192, w, lane); }
    h8 af[2][4];
    { const int r = lane & 31, i = r >> 3, hh = (r >> 2) & 1, jj = r & 3, query = 2 * hh + (i >> 1), head = 4 * (i & 1) + jj;
#pragma unroll
      for (int a = 0; a < 2; ++a)
#pragma unroll
        for (int ks = 0; ks < 4; ++ks) af[a][ks] = *(const h8*)(IQ + (rowg + 4 * a + query) * 512 + head * 64 + 16 * ks + 8 * H); }
    float wv[2][2][8];
#pragma unroll
    for (int a = 0; a < 2; ++a)
#pragma unroll
        for (int qs = 0; qs < 2; ++qs) { const float* wp = IKW + (rowg + 4 * a + 2 * H + qs) * 128 + 64;
            const f32x4 w0 = *(const f32x4*)wp, w1 = *(const f32x4*)(wp + 4);
#pragma unroll
            for (int h = 0; h < 4; ++h) { wv[a][qs][h] = w0[h] * 0.35355339059327373f; wv[a][qs][4 + h] = w1[h] * 0.35355339059327373f; } }
    asm volatile("s_waitcnt vmcnt(0)" ::: "memory");
#pragma unroll 1
    for (int srep = 0; srep < SCAN_REP; ++srep) {
    if (SCAN_REP > 1) { __syncthreads(); if (w == 0) { tau[lane] = (srep == SCAN_REP - 1 || SCAN_REAL) ? 0u : 0xFFFFFFFFu; cnt[lane] = 0u; if (lane < 3) pflag[lane] = 0u; } }
    if (SCAN_REP > 1) { stage_keys(IKN, b, 0, L + O_KT, w, lane); stage_keys(IKN, b, j < 1 ? j : 1, L + O_KT + 8192, w, lane); }
    const int rloc = 8 * w + 2 * H;
    const unsigned trash_off = (unsigned)(O_HIST + w * 512) + (unsigned)lane * 4u;
    LAS unsigned* const trashp = (LAS unsigned*)(L + trash_off);
    unsigned nHm = H ? 0u : 0xFFFFFFFFu; asm volatile("" : "+v"(nHm));
    int boff[4];
#pragma unroll
    for (int ks = 0; ks < 4; ++ks) { const int c = 2 * ks + H; boff[ks] = ((n >> 1) * 16 + ((((n & 1) << 3) | c) ^ ((n >> 1) & 7))) * 16; }
    h8 bfr[2][2][4];
    f32x16 acc0[2], acc1[2];
#define SCAN_MMA(ACC, PARX, SUB) do { _Pragma("unroll") for (int a = 0; a < 2; ++a) { _Pragma("unroll") for (int i = 0; i < 16; ++i) ACC[a][i] = 0.f; \
        _Pragma("unroll") for (int ks = 0; ks < 4; ++ks) ACC[a] = __builtin_amdgcn_mfma_f32_32x32x16_f16(af[a][ks], bfr[PARX][SUB][ks], ACC[a], 0, 0, 0); } } while (0)
    unsigned tau4[2][2], cnt4[2][2];
#pragma unroll
    for (int a = 0; a < 2; ++a)
#pragma unroll
        for (int qs = 0; qs < 2; ++qs) { tau4[a][qs] = 0u; cnt4[a][qs] = 0u; }
    auto scan_step = [&](const int T, auto last_tag, auto par_tag) __attribute__((always_inline)) {
        constexpr bool LAST = decltype(last_tag)::value; constexpr int PAR = decltype(par_tag)::value;

        asm volatile("s_waitcnt vmcnt(1) lgkmcnt(0)" ::: "memory");
        __builtin_amdgcn_s_barrier();
        asm volatile("" ::: "memory");
        {
            const unsigned fl = __builtin_amdgcn_readfirstlane(pflag[T % 3]);
            if (w == 0 && lane == 0) pflag[(T + 2) % 3] = 0u;
            if (fl) {
                if (n == 0) {
#pragma unroll
                    for (int a = 0; a < 2; ++a)
#pragma unroll
                        for (int qs = 0; qs < 2; ++qs) cnt[rloc + 4 * a + qs] = cnt4[a][qs];
                }
                asm volatile("s_waitcnt lgkmcnt(0)" ::: "memory");
#pragma unroll 1
                for (int r = 0; r < 8; ++r) { const int rr = 8 * w + r; const int c = __builtin_amdgcn_readfirstlane((int)cnt[rr]);
                    if (c > PRUNE_MIN) { int kept; const unsigned tprev = __builtin_amdgcn_readfirstlane(tau[rr]);
                        unsigned thr = wave_select256<false>((LAS unsigned*)(L + O_BUF + rr * 2048), c, tprev, lane, &kept);
#ifdef PRUNE_TWICE
                        { int kept2; (void)wave_select256<false>((LAS unsigned*)(L + O_BUF + rr * 2048), kept, thr ? thr - 1u : 0u, lane, &kept2); }
#endif
                        if (lane == 0) { tau[rr] = thr ? thr - 1u : 0u; cnt[rr] = (unsigned)kept; } } }
                asm volatile("s_waitcnt lgkmcnt(0)" ::: "memory");
#pragma unroll
                for (int a = 0; a < 2; ++a)
#pragma unroll
                    for (int qs = 0; qs < 2; ++qs) { tau4[a][qs] = tau[rloc + 4 * a + qs]; cnt4[a][qs] = cnt[rloc + 4 * a + qs]; }
#pragma unroll
                for (int a = 0; a < 2; ++a)
#pragma unroll
                    for (int qs = 0; qs < 2; ++qs) asm volatile("" : "+v"(tau4[a][qs]), "+v"(cnt4[a][qs]));
            }
        }
        { const int Tn = T + 3 <= j ? T + 3 : j; stage_keys(IKN, b, Tn, L + O_KT + (T % 3) * 8192, w, lane); }
        if (!LAST) {
            const LAS unsigned char* ktn = L + O_KT + ((T + 1) % 3) * 8192;
#pragma unroll
            for (int sb = 0; sb < 2; ++sb)
#pragma unroll
                for (int ks = 0; ks < 4; ++ks) bfr[PAR ^ 1][sb][ks] = *(const LAS h8*)(ktn + sb * 4096 + boff[ks]);
        }
        SCAN_MMA(acc1, PAR, 1);
#pragma unroll
        for (int sub = 0; sub < 2; ++sub) {
            if (sub == 1 && !LAST) SCAN_MMA(acc0, PAR ^ 1, 0);
            f32x16 (&acc_s)[2] = *(sub == 0 ? &acc0 : &acc1);
            const int skey = 64 * T + 32 * sub + n;
            unsigned keyv[2][2];
#pragma unroll
            for (int a = 0; a < 2; ++a)
#pragma unroll
                for (int qs = 0; qs < 2; ++qs) {
                    float s0 = 0.f, s1 = 0.f;
#pragma unroll
                    for (int h = 0; h < 4; ++h) { s0 += wv[a][qs][h] * __builtin_amdgcn_fmed3f(acc_s[a][8 * qs + h], 0.f, 3.0e38f); s1 += wv[a][qs][4 + h] * __builtin_amdgcn_fmed3f(acc_s[a][8 * qs + 4 + h], 0.f, 3.0e38f); }
                    const unsigned key = pack_key_nz(s0 + s1, skey);
                    const bool kill = LAST && (skey > t0 + rloc + 4 * a + qs);
                    keyv[a][qs] = kill ? 0u : key;
                }
#pragma unroll
            for (int a = 0; a < 2; ++a)
#pragma unroll
                for (int qs = 0; qs < 2; ++qs) {
                    const unsigned key = keyv[a][qs];
                    const bool keep = key > tau4[a][qs];
                    const unsigned long long bal = __ballot(keep);
                    const unsigned lo = (unsigned)bal, hi = (unsigned)(bal >> 32);
                    const unsigned pre = __builtin_amdgcn_mbcnt_hi(hi, __builtin_amdgcn_mbcnt_lo(lo & nHm, 0u));
                    const unsigned own = (lo & nHm) | (hi & ~nHm);
                    LAS unsigned* const rowp = (LAS unsigned*)(L + O_BUF + (rloc + 4 * a + qs) * 2048) + (cnt4[a][qs] + pre);
                    *(keep ? rowp : trashp) = key;
                    cnt4[a][qs] += (unsigned)__builtin_popcount(own);
                }
        }
        { const unsigned mc = max(max(cnt4[0][0], cnt4[0][1]), max(cnt4[1][0], cnt4[1][1]));
          if (__any(mc > (unsigned)PRUNE_AT)) { if (lane == 0) pflag[(T + 1) % 3] = 1u; } }
        };
    {
        __builtin_amdgcn_s_barrier();
        asm volatile("" ::: "memory");
        stage_keys(IKN, b, j < 2 ? j : 2, L + O_KT + 2 * 8192, w, lane);
#pragma unroll
        for (int sb = 0; sb < 2; ++sb)
#pragma unroll
            for (int ks = 0; ks < 4; ++ks) bfr[0][sb][ks] = *(const LAS h8*)(L + O_KT + sb * 4096 + boff[ks]);
        SCAN_MMA(acc0, 0, 0);
    }
    using TagF = std::integral_constant<bool, false>; using TagT = std::integral_constant<bool, true>; using P0 = std::integral_constant<int, 0>; using P1 = std::integral_constant<int, 1>;
    int T = 0;
#pragma unroll 1
    for (; T + 1 < j; T += 2) { scan_step(T, TagF{}, P0{}); scan_step(T + 1, TagF{}, P1{}); }
    if (T < j) { scan_step(T, TagF{}, P0{}); scan_step(j, TagT{}, P1{}); }
    else scan_step(j, TagT{}, P0{});
#undef SCAN_MMA
    if (n == 0) {
#pragma unroll
        for (int a = 0; a < 2; ++a)
#pragma unroll
            for (int qs = 0; qs < 2; ++qs) cnt[rloc + 4 * a + qs] = cnt4[a][qs];
    }
    asm volatile("s_waitcnt vmcnt(0) lgkmcnt(0)" ::: "memory");
    }
#pragma unroll 1
    for (int r = 0; r < 8; ++r) { const int rr = 8 * w + r; const int c = __builtin_amdgcn_readfirstlane((int)cnt[rr]);
        if (c > 256) { int kept; (void)wave_select256<true>((LAS unsigned*)(L + O_BUF + rr * 2048), c, __builtin_amdgcn_readfirstlane(tau[rr]), lane, &kept); if (lane == 0) cnt[rr] = 256u; } }
    asm volatile("s_waitcnt lgkmcnt(0)" ::: "memory");
#pragma unroll 1
    for (int r2 = 0; r2 < 8 * ATT_REP; ++r2) { const int r = r2 & 7; const int rr = 8 * w + r;
        if (ATT_FULL_PATH && j >= 4) attn_row_wave<true>(F, b, t0 + rr, (const LAS unsigned*)(L + O_BUF + rr * 2048), 256, L + O_BUF + (8 * w) * 2048 + 1024, lane, r2 >= 8);
        else attn_row_wave<false>(F, b, t0 + rr, (const LAS unsigned*)(L + O_BUF + rr * 2048), __builtin_amdgcn_readfirstlane((int)cnt[rr]), L + O_BUF + (8 * w) * 2048 + 1024, lane, r2 >= 8); }
    __syncthreads();
}
#else
namespace ds {
constexpr int O_KEYS = 0, O_HIST = 32768, O_MISC = 33792, O_Q = 34816, O_LG = 36864, O_SEL = 45056, O_BKT = 46080, O_RB = 46592, O_END = 47616;
}
__device__ __forceinline__ unsigned pack_key(float v, int s) {
    unsigned u = __builtin_bit_cast(unsigned, v); u = (u == 0x80000000u) ? 0u : u;
    const unsigned m = (u >> 31) ? 0xFFFFFFFFu : 0x80000000u;
    return ((u ^ m) & 0xFFFFE000u) | (unsigned)(8191 - s);
}
__device__ __forceinline__ void block_select256(LAS unsigned* keys, int n, LAS unsigned* hist, LAS unsigned* misc, int tid, int lane, int wave) {
    unsigned prefix = 0u, need = 256u;
#pragma unroll 1
    for (int r = 0; r < 4; ++r) {
        const int shift = 24 - 8 * r;
        if (tid < 256) hist[tid] = 0u;
        __syncthreads();
        for (int i = tid; i < n; i += NTHR) { const unsigned k = keys[i];
            if (r == 0 || (k >> (shift + 8)) == (prefix >> (shift + 8))) __hip_atomic_fetch_add(hist + ((k >> shift) & 255u), 1u, __ATOMIC_RELAXED, __HIP_MEMORY_SCOPE_WORKGROUP); }
        __syncthreads();
        if (wave == 0) {
            const int b0 = 4 * (63 - lane);
            const v4u h4 = *(const LAS v4u*)(hist + b0);
            const unsigned s = h4.x + h4.y + h4.z + h4.w;
            unsigned incl = s;
#pragma unroll
            for (int o = 1; o < 64; o <<= 1) { const unsigned t = __shfl_up(incl, o); if (lane >= o) incl += t; }
            const unsigned excl = incl - s;
            if (incl >= need && excl < need) {
                unsigned c = excl; int bin = b0 + 3;
                if (c + h4.w >= need) bin = b0 + 3; else { c += h4.w; if (c + h4.z >= need) bin = b0 + 2; else { c += h4.z; if (c + h4.y >= need) bin = b0 + 1; else { c += h4.y; bin = b0; } } }
                misc[0] = prefix | ((unsigned)bin << shift); misc[1] = need - c;
            }
        }
        __syncthreads();
        prefix = misc[0]; need = misc[1];
        __syncthreads();
    }
}
__device__ __forceinline__ void dsa_tables(const Ctx& F) {
    LAS int* bkt = (LAS int*)(F.lds + ds::O_BKT); LAS float* rb = (LAS float*)(F.lds + ds::O_RB);
    if (F.tid < 128) { const int dd = F.tid; int bk = dd;
        if (dd >= 16) { const int lg = 16 + (int)(logf((float)dd / 16.0f) / 2.0794415416798357f * 16.0f); bk = lg < 31 ? lg : 31; }
        bkt[dd] = bk; }
    if (F.tid < 256) rb[F.tid] = F.in[11][F.tid];
    __syncthreads();
}
__device__ __forceinline__ void dsa_row(const Ctx& F, int b, int t) {
    using namespace ds;
    const int tid = F.tid, lane = F.lane, wave = F.wave;
    LAS unsigned char* L = F.lds;
    LAS unsigned* keys = (LAS unsigned*)(L + O_KEYS); LAS unsigned* hist = (LAS unsigned*)(L + O_HIST); LAS unsigned* misc = (LAS unsigned*)(L + O_MISC);
    LAS float* qs = (LAS float*)(L + O_Q); LAS float* lg = (LAS float*)(L + O_LG); LAS int* sel = (LAS int*)(L + O_SEL);
    LAS int* bkt = (LAS int*)(L + O_BKT); LAS float* rb = (LAS float*)(L + O_RB);
    const size_t row = (size_t)b * SEQ + t; const int n = t + 1;
    const unsigned short* IQ = (const unsigned short*)(F.ws + WS_IQ); const unsigned short* IKN = (const unsigned short*)(F.ws + WS_IKN);
    const float* IKW = (const float*)(F.ws + WS_IKW); const bf16* AQ = (const bf16*)(F.ws + WS_AQ); const bf16* KV = (const bf16*)(F.ws + WS_KV);
    bf16* OB = (bf16*)(F.ws + WS_OB);
    {
        const int head = tid & 7;
        h8 qh[8];
#pragma unroll
        for (int j = 0; j < 8; ++j) qh[j] = *(const h8*)(IQ + row * 512 + head * 64 + 8 * j);
        const float wh = IKW[row * 128 + 64 + head] * 0.35355339059327373f;
        for (int s0 = 0; s0 < n; s0 += 64) {
            const int s = s0 + (tid >> 3); float v = 0.f;
            if (s < n) {
                const unsigned short* kp = IKN + ((size_t)b * SEQ + s) * 64; float dot = 0.f;
#pragma unroll
                for (int j = 0; j < 8; ++j) { const h8 kk = *(const h8*)(kp + 8 * j);
                    dot = __builtin_amdgcn_fdot2((h2){qh[j][0], qh[j][1]}, (h2){kk[0], kk[1]}, dot, false);
                    dot = __builtin_amdgcn_fdot2((h2){qh[j][2], qh[j][3]}, (h2){kk[2], kk[3]}, dot, false);
                    dot = __builtin_amdgcn_fdot2((h2){qh[j][4], qh[j][5]}, (h2){kk[4], kk[5]}, dot, false);
                    dot = __builtin_amdgcn_fdot2((h2){qh[j][6], qh[j][7]}, (h2){kk[6], kk[7]}, dot, false); }
                v = wh * fmaxf(dot, 0.f);
            }
            v += __shfl_xor(v, 1); v += __shfl_xor(v, 2); v += __shfl_xor(v, 4);
            if (head == 0 && s < n) keys[s] = pack_key(v, s);
        }
    }
    __syncthreads();
    unsigned thr = 0u;
    if (n > 256) { block_select256(keys, n, hist, misc, tid, lane, wave); thr = misc[0]; }
    __syncthreads();
    {
        int cnt = 0;
#pragma unroll 1
        for (int i = 0; i < 16; ++i) { const int idx = wave * 1024 + i * 64 + lane; const bool keep = idx < n && keys[idx] >= thr;
            cnt += __builtin_popcountll(__ballot(keep)); }
        if (lane == 0) misc[8 + wave] = (unsigned)cnt;
        __syncthreads();
        int off = 0;
        for (int ww = 0; ww < wave; ++ww) off += (int)misc[8 + ww];
#pragma unroll 1
        for (int i = 0; i < 16; ++i) { const int idx = wave * 1024 + i * 64 + lane; const unsigned k = idx < n ? keys[idx] : 0u; const bool keep = idx < n && k >= thr;
            const unsigned long long bal = __ballot(keep);
            if (keep) sel[off + __builtin_popcountll(bal & ((1ull << lane) - 1ull))] = 8191 - (int)(k & 8191u);
            off += __builtin_popcountll(bal); }
    }
    const int nsel = n < 256 ? n : 256;
    { const int hd = tid >> 6, dd = tid & 63; qs[((hd >> 2) * 64 + dd) * 4 + (hd & 3)] = bf2f(AQ[row * 512 + tid]); }
    __syncthreads();
    {
        const int j = tid & 255, grp = tid >> 8;
        if (j < nsel) {
            const int sidx = sel[j]; const bf16* kp = KV + ((size_t)b * SEQ + sidx) * 256 + grp * 64;
            f32x4 a = (f32x4){0.f, 0.f, 0.f, 0.f};
#pragma unroll 1
            for (int c = 0; c < 8; ++c) { const v4u kk = *(const v4u*)(kp + 8 * c);
                const float kf[8] = {bflo(kk.x), bfhi(kk.x), bflo(kk.y), bfhi(kk.y), bflo(kk.z), bfhi(kk.z), bflo(kk.w), bfhi(kk.w)};
#pragma unroll
                for (int e = 0; e < 8; ++e) a += *(const LAS f32x4*)(qs + (grp * 64 + 8 * c + e) * 4) * kf[e]; }
            const float a0 = a[0], a1 = a[1], a2 = a[2], a3 = a[3];
            const int dist = t - sidx; const int bk = dist < 128 ? bkt[dist] : 31;
            lg[(grp * 4 + 0) * 256 + j] = a0 + rb[bk * 8 + grp * 4 + 0]; lg[(grp * 4 + 1) * 256 + j] = a1 + rb[bk * 8 + grp * 4 + 1];
            lg[(grp * 4 + 2) * 256 + j] = a2 + rb[bk * 8 + grp * 4 + 2]; lg[(grp * 4 + 3) * 256 + j] = a3 + rb[bk * 8 + grp * 4 + 3];
        }
    }
    __syncthreads();
    {
        float v[4]; float mx = -3.0e38f;
#pragma unroll
        for (int i = 0; i < 4; ++i) { const int j = lane + 64 * i; v[i] = j < nsel ? lg[wave * 256 + j] : -3.0e38f; mx = fmaxf(mx, v[i]); }
#pragma unroll
        for (int o = 1; o < 64; o <<= 1) mx = fmaxf(mx, __shfl_xor(mx, o));
        float sm = 0.f;
#pragma unroll
        for (int i = 0; i < 4; ++i) { const int j = lane + 64 * i; v[i] = j < nsel ? __expf(v[i] - mx) : 0.f; sm += v[i]; }
        sm = wave_sum(sm); const float inv = 1.0f / sm;
#pragma unroll
        for (int i = 0; i < 4; ++i) { const int j = lane + 64 * i; lg[wave * 256 + j] = v[i] * inv; }
    }
    __syncthreads();
    {
        const int e = tid & 127, grp = e >> 6, r = tid >> 7, head = grp * 4 + r; float acc = 0.f;
        const bf16* vp = KV + (size_t)b * SEQ * 256 + 128 + e;
        for (int j = 0; j < nsel; ++j) acc += lg[head * 256 + j] * bf2f(vp[(size_t)sel[j] * 256]);
        OB[row * 512 + head * 64 + (e & 63)] = (bf16)f2bf(acc);
    }
    __syncthreads();
}
#endif
__device__ __forceinline__ void fill_zero_bf16(const Ctx& F, bf16* p, size_t nelem) {
    v4u* q = (v4u*)p; const size_t n16 = nelem / 8;
    for (size_t i = (size_t)F.bid * NTHR + F_TID; i < n16; i += (size_t)F.G * NTHR) q[i] = (v4u){0u, 0u, 0u, 0u};
}
#ifndef STAGGER7
#define STAGGER7 0
#endif
#ifndef ALIGN7
#define ALIGN7 1
#endif
#ifndef ALIGN1
#define ALIGN1 1
#endif
#ifndef XBAR_PROBE
#define XBAR_PROBE 0
#endif
#ifndef P6_REP
#define P6_REP 1
#endif
#ifndef P5_REP
#define P5_REP 1
#endif
#ifndef P3_REP
#define P3_REP 1
#endif
#ifndef P1_REP
#define P1_REP 1
#endif
#ifndef P9_REP
#define P9_REP 1
#endif
#ifndef HG_REP
#define HG_REP 1
#endif
#ifndef P0_REP
#define P0_REP 1
#endif
#ifndef P2_REP
#define P2_REP 1
#endif
#ifndef P8_REP
#define P8_REP 1
#endif
#ifndef DSA_REP
#define DSA_REP 1
#endif
constexpr int LW_PER_UNIT = 8;
static_assert(LW_ITEMS % LW_PER_UNIT == 0, "filler units");
#ifndef P4_REP
#define P4_REP 1
#endif
__device__ __forceinline__ void p4_mixers(const Ctx& F, const int qset) {
    LAS unsigned* misc = (LAS unsigned*)(F.lds + MISC_OFF);
#if 0
#else
    dsa_tables(F);
    gu32* qbase = (gu32*)(F.ws + WS_CTL) + CW_Q + 512 * qset;
    const unsigned pb = xb_xcc_id() & 3u;
    if (F_TID == 0) misc[5] = 0u;
    for (;;) {
        if (F_TID == 0) {
            unsigned st = misc[5], kind = 0xffffffffu, val = 0u;
            while (st < 6u) {
                const unsigned qi = st < 4u ? 1u + ((pb + st) & 3u) : (st == 4u ? 0u : 5u);
                const unsigned q = __hip_atomic_fetch_add(qbase + 64 * qi, 1u, __ATOMIC_RELAXED, __HIP_MEMORY_SCOPE_AGENT);
                if (q < (qi == 0u ? (unsigned)HG_UNITS : (qi == 5u ? (unsigned)(LW_ITEMS / LW_PER_UNIT) : 128u))) { kind = qi; val = q; break; }
                ++st;
            }
            misc[5] = st; misc[4] = kind; misc[6] = val;
        }
        __syncthreads();
        int zofs = 0; asm volatile("" : "+v"(zofs));
        const LAS unsigned* mq = (const LAS unsigned*)(F.lds + MISC_OFF + zofs);
        const unsigned kind = __builtin_amdgcn_readfirstlane(mq[4]), val = __builtin_amdgcn_readfirstlane(mq[6]);
        __syncthreads();
        if (kind == 0xffffffffu) break;
        if (kind == 5u) {
            for (int i = 0; i < LW_PER_UNIT / NWAVES; ++i) late_weight_item(F, (int)val * LW_PER_UNIT + i * NWAVES + F.wave);
            continue;
        }
        if (kind == 0u) {
#if !DBG_SKIP_HGRN
            for (int hrep = 0; hrep < HG_REP; ++hrep) hgrn_segment<2>(F, (int)val / HG_NSEG, (int)val % HG_NSEG);
#endif
            continue;
        }
        for (int rep = 0; rep < DSA_REP; ++rep) dsa_unit(F, (int)kind - 1, 127 - (int)val);
    }
#endif
}

__global__ void __launch_bounds__(NTHR, 2) mk_fwd(Args args) {
    extern __shared__ __attribute__((aligned(16))) unsigned char lds_raw[];
    Ctx F;
    F.lds = (LAS unsigned char*)lds_raw; F.wave = __builtin_amdgcn_readfirstlane((int)threadIdx.x >> 6);
    F.G = gridDim.x; F.bid = blockIdx.x; F.in = args.in; F.out = args.out; F.ws = args.ws;
    volatile LAS unsigned* MISC = (volatile LAS unsigned*)(F.lds + MISC_OFF);
    if (F_TID < 64) MISC[F_TID] = 0u;
    __syncthreads();
    const int lo = args.ph_lo, hi = args.ph_hi;
    unsigned* barw = (unsigned*)(F.ws + WS_CTL) + CW_BAR + (MK_N_LAUNCHES == 1 ? 0 : 0);
    XcdBarrier bar; bar.bar = barw; bar.x = 0; bar.st = nullptr;
    if (hi - lo > 1) bar = xcd_barrier_post(barw, MISC, F_TID == 0);
#define IN(k) (lo <= (k) && (k) < hi)
#ifdef ONLYP
#define PH_ON(k) ((k) == ONLYP)
#else
#define PH_ON(k) true
#endif
#define SEAM(k) do { if (IN(k) && IN((k) + 1)) xcd_barrier(bar, F_TID == 0); } while (0)

    if (PH_ON(0) && IN(0)) { for (int rep = 0; rep < P0_REP; ++rep) p0_prologue(F); } SEAM(0);
    if (PH_ON(1) && IN(1)) {
        pg8::Gemm g{(const pg8::bf16_t*)(F.ws + WS_HM), (const pg8::bf16_t*)(F.ws + WS_WIN), M, NPROJ, DM}; pg8::StaticOrder S; S.init(M, NPROJ, F.G, F.bid);
        epi::EpiProj E{F.ws};
        for (int rep = 0; rep < P1_REP; ++rep) pg8::gemm_phase<epi::EpiProj, pg8::StaticOrder, (ALIGN1 != 0), true>(F.lds, g, S, E, F.wave);
    } SEAM(1);
    if (PH_ON(2) && IN(2)) { for (int rep = 0; rep < P2_REP; ++rep) { p2_norms(F); for (int u = F.bid; u < HG_UNITS; u += F.G) hgrn_segment<1>(F, u / HG_NSEG, u % HG_NSEG); } } SEAM(2);
    if (PH_ON(3) && IN(3)) {
        hgrn_prefix(F);
        pg8::Gemm g{(const pg8::bf16_t*)(F.ws + WS_CQN), (const pg8::bf16_t*)(F.ws + WS_WQI), M, 1024, 256}; pg8::StaticOrder S; S.init(M, 1024, F.G, F.bid);
        epi::EpiQI E{F.ws};
        for (int rep = 0; rep < P3_REP; ++rep) pg8::gemm_phase<epi::EpiQI, pg8::StaticOrder, true, true>(F.lds, g, S, E, F.wave);
    } SEAM(3);
#if XBAR_PROBE > 0
    for (int i = 0; i < XBAR_PROBE; ++i) xcd_barrier(bar, F_TID == 0);
#endif
    if (PH_ON(4) && IN(4)) { p4_mixers(F, 0);
#if P4_REP > 1
        xcd_barrier(bar, F_TID == 0); p4_mixers(F, 1);
#endif
    } SEAM(4);
    if (PH_ON(5) && IN(5)) {
        pg8::Gemm g{(const pg8::bf16_t*)((unsigned char*)F.out + OAB_OFF), (const pg8::bf16_t*)(F.ws + WS_WMH), M, 1024, 1024}; pg8::StaticOrder S; S.init(M, 1024, F.G, F.bid);
        epi::EpiMixM E{F.ws};
        for (int rep = 0; rep < P5_REP; ++rep) pg8::gemm_phase<epi::EpiMixM, pg8::StaticOrder, true, true>(F.lds, g, S, E, F.wave);
    } SEAM(5);
    if (PH_ON(6) && IN(6)) {
        pg8::Gemm g{(const pg8::bf16_t*)(F.ws + WS_MIX), (const pg8::bf16_t*)(F.ws + WS_WO), M, 1024, 1024}; pg8::StaticOrder S; S.init(M, 1024, F.G, F.bid);
        epi::EpiWo E{F.in[0], (pg8::bf16_t*)(F.ws + WS_XG), (float*)(F.ws + WS_CTL) + CW_ROWSS};
#if P6_REP > 1
        { epi::EpiWo E2{F.in[0], (pg8::bf16_t*)(F.ws + WS_XG), (float*)(F.ws + WS_QH)}; pg8::gemm_phase<epi::EpiWo, pg8::StaticOrder, true, true>(F.lds, g, S, E2, F.wave); }
#endif
        pg8::gemm_phase<epi::EpiWo, pg8::StaticOrder, true, true>(F.lds, g, S, E, F.wave);
    } SEAM(6);
    if (PH_ON(7) && IN(7)) {
        pg8::Gemm g{(const pg8::bf16_t*)(F.ws + WS_XG), (const pg8::bf16_t*)(F.ws + WS_WMI), M, DFF, 1024}; pg8::StaticOrder S; S.init(M, DFF, F.G, F.bid);
        epi::EpiRelu2 E{(pg8::bf16_t*)(F.ws + WS_HID), (const float*)(F.ws + WS_CTL) + CW_ROWSS};
#if STAGGER7 > 0
        { const int grp = (F.bid >> 3) & 3; for (int i = 0; i < grp * STAGGER7; ++i) __builtin_amdgcn_s_sleep(32); }
#endif
        for (int rep = 0; rep < P9_REP; ++rep) pg8::gemm_phase<epi::EpiRelu2, pg8::StaticOrder, (ALIGN7 != 0), true>(F.lds, g, S, E, F.wave);
    } SEAM(7);
    if (PH_ON(8) && IN(8)) {
        pg8::Gemm g{(const pg8::bf16_t*)(F.ws + WS_HID), (const pg8::bf16_t*)(F.ws + WS_WMO), M, 1024, DFF}; pg8::StaticOrder S; S.init(M, 1024, F.G, F.bid);
        if (args.fuse) {
            epi::EpiFinal E{(const pg8::bf16_t*)(F.ws + WS_XG), F.out, F.in[17], (float*)(F.ws + WS_CTL) + CW_ROWSS2, (unsigned*)(F.ws + WS_CTL) + CW_PCNT};
            pg8::gemm_phase<epi::EpiFinal, pg8::StaticOrder, true, true>(F.lds, g, S, E, F.wave);
        } else {
            epi::EpiResid E{(const pg8::bf16_t*)(F.ws + WS_XG), F.out};
            pg8::gemm_phase<epi::EpiResid, pg8::StaticOrder, true, true>(F.lds, g, S, E, F.wave);
        }
    }
    if (!args.fuse) { SEAM(8); if (PH_ON(9) && IN(9)) { p11_final(F); } }
#undef IN
#undef SEAM
}

extern "C" void kernel_launch(void* const* d_in, const int* in_sizes, int n_in, void* d_out, int out_size, void* d_ws, size_t ws_size, hipStream_t stream) {
    static int grid = 0;
    if (grid == 0) {
        if (n_in != 18 || in_sizes[0] != M * DM || out_size != M * DM || ws_size < WS_END) {
            fprintf(stderr, "kernel_launch: unexpected shapes (n_in %d, in0 %d, out %d, ws %zu); nothing launched\n", n_in, n_in > 0 ? in_sizes[0] : -1, out_size, ws_size); grid = -1; return; }
        int dev = 0, cus = 0, per_cu = 0;
        if (hipGetDevice(&dev) != hipSuccess || hipDeviceGetAttribute(&cus, hipDeviceAttributeMultiprocessorCount, dev) != hipSuccess) { grid = -1; return; }
        if (hipFuncSetAttribute((const void*)mk_fwd, hipFuncAttributeMaxDynamicSharedMemorySize, LDS_BYTES) != hipSuccess) { fprintf(stderr, "kernel_launch: hipFuncSetAttribute failed\n"); grid = -1; return; }
        if (hipOccupancyMaxActiveBlocksPerMultiprocessor(&per_cu, (const void*)mk_fwd, NTHR, LDS_BYTES) != hipSuccess || per_cu < 1) {
            fprintf(stderr, "kernel_launch: occupancy query reports %d workgroups per CU\n", per_cu); }
        (void)hipGetLastError();
        grid = cus;
    }
    if (grid < 0) return;
    if (hipMemsetAsync((char*)d_ws + WS_CTL, 0, CTL_ZERO_BYTES, stream) != hipSuccess) return;
    Args a{};
    for (int i = 0; i < 18; ++i) a.in[i] = (const float*)d_in[i];
    a.out = (float*)d_out; a.ws = (unsigned char*)d_ws;
#if MK_N_LAUNCHES == 1
    a.ph_lo = 0; a.ph_hi = NPHASE;
    a.fuse = (MK_N_LAUNCHES == 1 && (grid == 256 || grid == 512)) ? 1 : 0;
    hipLaunchKernelGGL(mk_fwd, dim3(grid), dim3(NTHR), LDS_BYTES, stream, a);
#else
    for (int p = 0; p < NPHASE; ++p) { a.ph_lo = p; a.ph_hi = p + 1; hipLaunchKernelGGL(mk_fwd, dim3(grid), dim3(NTHR), LDS_BYTES, stream, a); }
#endif
}
```

```cpp
#include <hip/hip_runtime.h>
#include <cstdio>
#include <cstdint>
#include <type_traits>
namespace pg8 {
#define PG8_LAS __attribute__((address_space(3)))
typedef unsigned short bf16_t;
typedef short bf16x8 __attribute__((ext_vector_type(8)));
typedef float f32x4 __attribute__((ext_vector_type(4)));
typedef unsigned u32x4 __attribute__((ext_vector_type(4)));
constexpr int BM = 256, BK = 64, HALF = 128, HTB = HALF * BK * 2  , STAGE_BYTES = 8 * HTB, NXCD = 8, WGM = 8;

__host__ __device__ __forceinline__ int lds_byte(int r, int c) { const int st = (r >> 4) * 2 + (c >> 5), rr = r & 15, cc = c & 31, ob = rr * 64 + cc * 2; return st * 1024 + (ob ^ (((ob >> 9) & 1) << 5)); }
__host__ __device__ __forceinline__ void stage_rc(int b, int& R, int& C) { const int st = b / 1024, sb = b % 1024, swz = sb ^ (((sb >> 9) & 1) << 5); R = (st >> 1) * 16 + swz / 64; C = (st & 1) * 32 + (swz % 64) / 2; }
__host__ __device__ __forceinline__ int perm32(int rho) { const int n = rho >> 4, i = rho & 15; return 8 * (i >> 2) + 4 * n + (i & 3); }

struct Unit { int pm, pn; };
struct Gemm { const bf16_t* A; const bf16_t* Bt; int M, N, K; };

struct StaticOrder {
    int nM, nN, nwg, G, c;
    __host__ __device__ void init(int M, int N, int G_, int c_) { nM = M / BM; nN = N / BM; nwg = nM * nN; G = G_; c = c_; }
    __host__ __device__ bool next(int i, Unit& u) const {
        const long L = (long)i * G + c; if (L >= nwg) return false;
        int wgid = (int)L; { const int q = nwg / NXCD, r = nwg % NXCD, xcd = wgid % NXCD, off = wgid / NXCD; wgid = (xcd < r ? xcd * (q + 1) : r * (q + 1) + (xcd - r) * q) + off; }
        const int nig = WGM * nN, gid = wgid / nig, fm = gid * WGM, gsz = (nM - fm) < WGM ? (nM - fm) : WGM;
        u.pm = fm + ((wgid % nig) % gsz); u.pn = (wgid % nig) / gsz; return true;
    }
    __device__ __forceinline__ void a_ready(const Unit&) const {}
    __device__ __forceinline__ void done(const Unit&) const {}
};
typedef __bf16 bf16x2_t __attribute__((ext_vector_type(2)));
typedef float f32x2_t __attribute__((ext_vector_type(2)));
__device__ __forceinline__ unsigned cvt_pk_bf16(float lo, float hi) { const f32x2_t v = {lo, hi}; const bf16x2_t b = __builtin_convertvector(v, bf16x2_t); return __builtin_bit_cast(unsigned, b); }
typedef float f32x2 __attribute__((ext_vector_type(2)));
template <class Epi, class Sched, bool ALIGN_EPI = false, bool SP2 = false>
__device__ __forceinline__ void gemm_phase(PG8_LAS unsigned char* lds, const Gemm g, const Sched& S, const Epi& E, const int wid  ) {
    int lane_; asm volatile("v_mbcnt_lo_u32_b32 %0, -1, 0\n\tv_mbcnt_hi_u32_b32 %0, -1, %0" : "=v"(lane_));
    const int lane = lane_, tid = wid * 64 + lane, wr = wid >> 2, wc = wid & 3, fr = lane & 15, fq = lane >> 4;
    const int K = g.K, nt = K / BK;
    unsigned voffA[2], voffB[2];
#pragma unroll
    for (int i = 0; i < 2; ++i) { int R, C; stage_rc(tid * 16 + i * 8192, R, C); const int Rb = Epi::PERM ? ((R & ~31) + perm32(R & 31)) : R;
        voffA[i] = (unsigned)(R * K + C) * 2u; voffB[i] = (unsigned)(Rb * K + C) * 2u; }
    const size_t kstep = (size_t)(BK * 2);
    const size_t hstep = (size_t)HALF * K * 2;
    const size_t tstep = 2 * hstep;
    const unsigned ldsw = (unsigned)wid * 1024u;
    const int aoff = lds_byte(wr * 64 + fr, fq * 8), boff = lds_byte(wc * 32 + fr, fq * 8);
#define PG8_SA(b, h) (((b) * 2 + (h)) * HTB)
#define PG8_SB(b, h) ((4 + (b) * 2 + (h)) * HTB)
#define PG8_STAGE(bufoff, gbase, voff) do { _Pragma("unroll") for (int _i = 0; _i < 2; ++_i) \
        __builtin_amdgcn_global_load_lds((const unsigned*)((const char*)(gbase) + (voff)[_i]), (PG8_LAS unsigned*)(lds + (bufoff) + ldsw + _i * 8192), 16, 0, 0); } while (0)
#define PG8_LDA(dst, b, h) do { _Pragma("unroll") for (int m = 0; m < 4; ++m) _Pragma("unroll") for (int k = 0; k < 2; ++k) dst[m][k] = *(const PG8_LAS bf16x8*)(lds + PG8_SA(b, h) + aoff + m * 2048 + k * 1024); } while (0)
#define PG8_LDB(dst, b, h) do { _Pragma("unroll") for (int n = 0; n < 2; ++n) _Pragma("unroll") for (int k = 0; k < 2; ++k) dst[n][k] = *(const PG8_LAS bf16x8*)(lds + PG8_SB(b, h) + boff + n * 2048 + k * 1024); } while (0)
#define PG8_MMA(ai, bj, At, Bt) do { __builtin_amdgcn_s_setprio(1); _Pragma("unroll") for (int m = 0; m < 4; ++m) _Pragma("unroll") for (int n = 0; n < 2; ++n) _Pragma("unroll") for (int k = 0; k < 2; ++k) \
        acc[ai][bj][m][n] = __builtin_amdgcn_mfma_f32_16x16x32_bf16(Bt[n][k], At[m][k], acc[ai][bj][m][n], 0, 0, 0); __builtin_amdgcn_s_setprio(0); } while (0)
#define PG8_WAIT_V(n) asm volatile("s_waitcnt vmcnt(" #n ")" ::: "memory")
#define PG8_WAIT_L(n) asm volatile("s_waitcnt lgkmcnt(" #n ")" ::: "memory")
#define PG8_BAR __builtin_amdgcn_s_barrier()
#define PG8_SCHED __builtin_amdgcn_sched_barrier(0)
    Unit cur, nxt; int ui = 0;
    if (!S.next(0, cur)) return;
    f32x4 acc[2][2][4][2];
#pragma unroll
    for (int a = 0; a < 2; ++a)
#pragma unroll
        for (int b = 0; b < 2; ++b)
#pragma unroll
            for (int m = 0; m < 4; ++m)
#pragma unroll
                for (int n = 0; n < 2; ++n) acc[a][b][m][n] = (f32x4){0.f, 0.f, 0.f, 0.f};
    bf16x8 At[4][2], B0[2][2], B1[2][2];
    const char* cA = (const char*)g.A + (size_t)cur.pm * tstep; const char* cB = (const char*)g.Bt + (size_t)cur.pn * tstep;
    S.a_ready(cur);
    if constexpr (SP2) {
        PG8_STAGE(PG8_SB(0, 0), cB, voffB); PG8_STAGE(PG8_SB(0, 1), cB + hstep, voffB); PG8_STAGE(PG8_SA(0, 0), cA, voffA); PG8_STAGE(PG8_SA(0, 1), cA + hstep, voffA);
        if (wr == 1) PG8_BAR;
        PG8_WAIT_V(2); PG8_BAR;
        PG8_STAGE(PG8_SB(1, 0), cB + kstep, voffB); PG8_STAGE(PG8_SA(1, 0), cA + kstep, voffA); PG8_STAGE(PG8_SB(1, 1), cB + hstep + kstep, voffB);
        PG8_WAIT_V(6); PG8_BAR;
    } else {
        PG8_STAGE(PG8_SB(0, 0), cB, voffB); PG8_STAGE(PG8_SA(0, 0), cA, voffA); PG8_STAGE(PG8_SB(0, 1), cB + hstep, voffB); PG8_STAGE(PG8_SA(0, 1), cA + hstep, voffA);
        if (wr == 1) PG8_BAR;
        PG8_WAIT_V(4); PG8_BAR;
        PG8_STAGE(PG8_SB(1, 0), cB + kstep, voffB); PG8_STAGE(PG8_SA(1, 0), cA + kstep, voffA); PG8_STAGE(PG8_SB(1, 1), cB + hstep + kstep, voffB);
        PG8_WAIT_V(6); PG8_BAR;
    }
    for (;;) {
        const bool has_next = S.next(ui + 1, nxt);
        const char* nA = has_next ? (const char*)g.A + (size_t)nxt.pm * tstep : cA; const char* nB = has_next ? (const char*)g.Bt + (size_t)nxt.pn * tstep : cB;
        _Pragma("unroll 1") for (int t = 0; t < nt; t += 2) {
            const bool last = (t == nt - 2);
            const char* a1 = cA + (size_t)(t + 1) * kstep;
            const char* a2 = last ? nA : cA + (size_t)(t + 2) * kstep; const char* b2 = last ? nB : cB + (size_t)(t + 2) * kstep;
            const char* a3 = a2 + kstep; const char* b3 = b2 + kstep;
            if (last && has_next) S.a_ready(nxt);
            if constexpr (Epi::HAS_MID) { if (t == (nt >> 1)) E.mid(acc, cur, wr, wc, fr, fq); }
            if constexpr (SP2) {
            PG8_LDB(B0, 0, 0); PG8_LDB(B1, 0, 1); PG8_SCHED; PG8_LDA(At, 0, 0); PG8_STAGE(PG8_SA(1, 1), a1 + hstep, voffA);
            PG8_WAIT_V(8); PG8_WAIT_L(0); PG8_BAR; PG8_MMA(0, 0, At, B0); PG8_MMA(0, 1, At, B1); PG8_BAR; PG8_SCHED;
            PG8_LDA(At, 0, 1); PG8_STAGE(PG8_SB(0, 0), b2, voffB); PG8_STAGE(PG8_SB(0, 1), b2 + hstep, voffB); PG8_STAGE(PG8_SA(0, 0), a2, voffA);
            PG8_WAIT_V(8); PG8_WAIT_L(0); PG8_BAR; PG8_MMA(1, 0, At, B0); PG8_MMA(1, 1, At, B1); PG8_BAR; PG8_SCHED;
            PG8_LDB(B0, 1, 0); PG8_LDB(B1, 1, 1); PG8_SCHED; PG8_LDA(At, 1, 0); PG8_STAGE(PG8_SA(0, 1), a2 + hstep, voffA);
            PG8_WAIT_V(8); PG8_WAIT_L(0); PG8_BAR; PG8_MMA(0, 0, At, B0); PG8_MMA(0, 1, At, B1); PG8_BAR; PG8_SCHED;
            PG8_LDA(At, 1, 1); PG8_STAGE(PG8_SB(1, 0), b3, voffB); PG8_STAGE(PG8_SB(1, 1), b3 + hstep, voffB); PG8_STAGE(PG8_SA(1, 0), a3, voffA);
            PG8_WAIT_V(8); PG8_WAIT_L(0); PG8_BAR; PG8_MMA(1, 0, At, B0); PG8_MMA(1, 1, At, B1); PG8_BAR; PG8_SCHED;
            } else {
            PG8_LDB(B0, 0, 0); PG8_SCHED; PG8_LDA(At, 0, 0); PG8_STAGE(PG8_SA(1, 1), a1 + hstep, voffA);
            PG8_WAIT_L(8); PG8_BAR; PG8_WAIT_L(0); PG8_MMA(0, 0, At, B0); PG8_BAR; PG8_SCHED;
            PG8_LDB(B1, 0, 1); PG8_STAGE(PG8_SB(0, 0), b2, voffB);
            PG8_BAR; PG8_WAIT_L(0); PG8_MMA(0, 1, At, B1); PG8_BAR;
            PG8_LDA(At, 0, 1); PG8_STAGE(PG8_SA(0, 0), a2, voffA);
            PG8_BAR; PG8_WAIT_L(0); PG8_MMA(1, 0, At, B0); PG8_BAR; PG8_SCHED;
            PG8_STAGE(PG8_SB(0, 1), b2 + hstep, voffB);
            PG8_WAIT_V(6); PG8_BAR; PG8_MMA(1, 1, At, B1); PG8_BAR;
            PG8_LDB(B0, 1, 0); PG8_SCHED; PG8_LDA(At, 1, 0); PG8_STAGE(PG8_SA(0, 1), a2 + hstep, voffA);
            PG8_WAIT_L(8); PG8_BAR; PG8_WAIT_L(0); PG8_MMA(0, 0, At, B0); PG8_BAR; PG8_SCHED;
            PG8_LDB(B1, 1, 1); PG8_STAGE(PG8_SB(1, 0), b3, voffB);
            PG8_BAR; PG8_WAIT_L(0); PG8_MMA(0, 1, At, B1); PG8_BAR;
            PG8_LDA(At, 1, 1); PG8_STAGE(PG8_SA(1, 0), a3, voffA);
            PG8_BAR; PG8_WAIT_L(0); PG8_MMA(1, 0, At, B0); PG8_BAR; PG8_SCHED;
            PG8_STAGE(PG8_SB(1, 1), b3 + hstep, voffB);
            PG8_WAIT_V(6); PG8_BAR; PG8_MMA(1, 1, At, B1); PG8_BAR;
            }
        }
        if constexpr (ALIGN_EPI) { if (wr == 0) PG8_BAR; }
        if constexpr (!Epi::AFTER_DRAIN) { E(acc, cur, wr, wc, fr, fq); S.done(cur); }
        if (!has_next) break;
#pragma unroll
        for (int a = 0; a < 2; ++a)
#pragma unroll
            for (int b = 0; b < 2; ++b)
#pragma unroll
                for (int m = 0; m < 4; ++m)
#pragma unroll
                    for (int n = 0; n < 2; ++n) acc[a][b][m][n] = (f32x4){0.f, 0.f, 0.f, 0.f};
        cur = nxt; cA = nA; cB = nB; ++ui;
        if constexpr (ALIGN_EPI) { if (wr == 1) PG8_BAR; }
    }
    PG8_WAIT_V(0);
    if constexpr (!ALIGN_EPI) { if (wr == 0) PG8_BAR; }
    PG8_BAR;
    if constexpr (Epi::AFTER_DRAIN) { E.fused(acc, cur, wr, wc, fr, fq, lds, wid, lane); S.done(cur); }
#undef PG8_SA
#undef PG8_SB
#undef PG8_STAGE
#undef PG8_LDA
#undef PG8_LDB
#undef PG8_MMA
#undef PG8_WAIT_V
#undef PG8_WAIT_L
#undef PG8_BAR
#undef PG8_SCHED
}
}

#ifndef MK_N_LAUNCHES
#define MK_N_LAUNCHES 1
#endif
#ifndef DBG_SKIP_HGRN
#define DBG_SKIP_HGRN 0
#endif
#ifndef P1_ALIGN
#define P1_ALIGN true
#endif
#ifndef P1_SP2
#define P1_SP2 true
#endif
#ifndef DBG_SKIP_DSA
#define DBG_SKIP_DSA 0
#endif

#define GAS __attribute__((address_space(1)))
#define LAS __attribute__((address_space(3)))
typedef unsigned short bf16;
typedef unsigned v4u __attribute__((ext_vector_type(4)));
typedef unsigned v2u __attribute__((ext_vector_type(2)));
typedef float f32x4 __attribute__((ext_vector_type(4)));
typedef short bf16x8 __attribute__((ext_vector_type(8)));
typedef _Float16 h2 __attribute__((ext_vector_type(2)));
typedef _Float16 h8 __attribute__((ext_vector_type(8)));
typedef GAS unsigned gu32;

constexpr int NWAVES = 8, NTHR = 512;
constexpr int BATCH = 4, SEQ = 8192, DM = 1024, M = BATCH * SEQ;
constexpr int HGW = 512, HGD = 128;
constexpr int NPROJ = 4864;
constexpr int DFF = 4096;
constexpr float EPS = 1e-6f;
constexpr int NPHASE = 10;

constexpr size_t MiB = 1u << 20;
constexpr size_t WS_CTL = 0, CTL_ZERO_BYTES = 1 * MiB;
constexpr size_t WS_WIN = 1 * MiB;
constexpr size_t WS_RMS = 10 * MiB + 512 * 1024;
constexpr size_t WS_LB = 10 * MiB + 768 * 1024;
constexpr size_t WS_WQI = 11 * MiB;
constexpr size_t WS_WMH = 12 * MiB;
constexpr size_t WS_WMA = 13 * MiB;
constexpr size_t WS_WO = 14 * MiB;
constexpr size_t WS_WMI = 16 * MiB;
constexpr size_t WS_WMO = 24 * MiB;
constexpr size_t WS_GA = 32 * MiB;
constexpr size_t WS_GB = 96 * MiB;
constexpr size_t WS_QH = 160 * MiB;
constexpr size_t WS_G = 192 * MiB;
constexpr size_t WS_VH = 256 * MiB;
constexpr size_t WS_SG = 288 * MiB;
constexpr size_t WS_CQ = 320 * MiB;
constexpr size_t WS_OB = 320 * MiB;
constexpr size_t WS_KV = 352 * MiB;
constexpr size_t WS_IKW = 368 * MiB;
constexpr size_t WS_CQN = 384 * MiB;
constexpr size_t WS_IKN = 400 * MiB;
constexpr size_t WS_HM = 416 * MiB;
constexpr size_t WS_XG = 32 * MiB;
constexpr size_t WS_AQ = 128 * MiB;
constexpr size_t WS_IQ = 480 * MiB;
constexpr size_t WS_MIX = 160 * MiB;
constexpr size_t WS_OA = 480 * MiB;
constexpr size_t WS_MIXP = 160 * MiB;
constexpr size_t WS_HID = 160 * MiB;
constexpr size_t WS_END = 512 * MiB;
constexpr size_t OAB_OFF = 32 * MiB;

constexpr int CW_Q = 64;
constexpr int CW_BAR = 4096;
constexpr int CW_ROWSS2 = 131072 + 32768;
constexpr int CW_PCNT = 131072 + 65536;
static_assert((CW_PCNT + 128) * 4 <= (int)CTL_ZERO_BYTES, "ctl region");
constexpr int CW_ROWSSQ = 131072 + 65536 + 256;
static_assert((CW_ROWSSQ + 32768) * 4 <= (int)CTL_ZERO_BYTES, "ctl region 2");
constexpr int CW_ROWSS = 131072;

constexpr int LDS_BYTES = 163840 - 1024;
constexpr int MISC_OFF = LDS_BYTES - 256;

#define LDS_WAIT() asm volatile("s_waitcnt lgkmcnt(0)" ::: "memory")
#define VM_WAIT() asm volatile("s_waitcnt vmcnt(0)" ::: "memory")
__device__ __forceinline__ unsigned f2bf(float f) { const __bf16 b = (__bf16)f; return (unsigned)__builtin_bit_cast(unsigned short, b); }
__device__ __forceinline__ unsigned pk2(float lo, float hi) { return pg8::cvt_pk_bf16(lo, hi); }
__device__ __forceinline__ float bf2f(unsigned short b) { return __builtin_bit_cast(float, ((unsigned)b) << 16); }
__device__ __forceinline__ float bflo(unsigned u) { return __builtin_bit_cast(float, u << 16); }
__device__ __forceinline__ float bfhi(unsigned u) { return __builtin_bit_cast(float, u & 0xffff0000u); }
__device__ __forceinline__ float wave_sum(float v) {
#pragma unroll
    for (int o = 1; o < 64; o <<= 1) v += __shfl_xor(v, o);
    return v;
}
__device__ __forceinline__ float sigmoidf_(float z) { return __builtin_amdgcn_rcpf(1.0f + __expf(-z)); }

struct Args { const float* in[18]; float* out; unsigned char* ws; int ph_lo, ph_hi, fuse; };

namespace epi {
#ifndef NT_STORES
#define NT_STORES 0
#endif
#if NT_STORES
#define ST_STREAM(ptr, val) __builtin_nontemporal_store((val), (ptr))
#else
#define ST_STREAM(ptr, val) (*(ptr) = (val))
#endif
using pg8::f32x4; using pg8::u32x4; using pg8::Unit; using pg8::cvt_pk_bf16; using pg8::bf16_t;
enum { X_NONE = 0, X_SIG = 1, X_SILU = 2, X_RELU2 = 3 };
template <int X> __device__ __forceinline__ float xf(float v) {
#ifdef DBG_CONSTGATE
    if (X == X_SIG) return 0.5f + 0.0f * fminf(fmaxf(v, -1.f), 1.f);
#endif
    if (X == X_SIG) return sigmoidf_(v);
    if (X == X_SILU) return v * sigmoidf_(v);
    if (X == X_RELU2) { const float r = fmaxf(v, 0.f); return r * r; }
    return v;
}
template <int X> __device__ __forceinline__ void store_bf16(const f32x4 (&acc)[2][2][4][2], bf16_t* base, int ldc, int row0, int col0, float sc) {
#pragma unroll
    for (int ai = 0; ai < 2; ++ai)
#pragma unroll
        for (int m = 0; m < 4; ++m) { bf16_t* rowp = base + (size_t)(row0 + ai * 128 + m * 16) * ldc + col0;
#pragma unroll
            for (int bj = 0; bj < 2; ++bj) { const f32x4 v0 = acc[ai][bj][m][0], v1 = acc[ai][bj][m][1];
                u32x4 w; w.x = cvt_pk_bf16(xf<X>(v0[0]) * sc, xf<X>(v0[1]) * sc); w.y = cvt_pk_bf16(xf<X>(v0[2]) * sc, xf<X>(v0[3]) * sc);
                w.z = cvt_pk_bf16(xf<X>(v1[0]) * sc, xf<X>(v1[1]) * sc); w.w = cvt_pk_bf16(xf<X>(v1[2]) * sc, xf<X>(v1[3]) * sc);
                *(u32x4*)(rowp + bj * 128) = w; } }
}
template <int B> __device__ __forceinline__ float ubf(unsigned x) { return (float)((x >> (8 * B)) & 255u); }
__device__ __forceinline__ void store_gate_u8(const f32x4 (&acc)[2][2][4][2], unsigned char* base, int ldc, int row0, int col0, float qmin) {
#pragma unroll
    for (int ai = 0; ai < 2; ++ai)
#pragma unroll
        for (int m = 0; m < 4; ++m) { unsigned char* rowp = base + (size_t)(row0 + ai * 128 + m * 16) * ldc + col0;
#pragma unroll
            for (int bj = 0; bj < 2; ++bj) { unsigned w[2];
#pragma unroll
                for (int n = 0; n < 2; ++n) { const f32x4 v = acc[ai][bj][m][n]; unsigned p = 0u;
                    p = __builtin_amdgcn_cvt_pk_u8_f32(fmaxf(xf<X_SIG>(v[0]) * 255.f, qmin), 0u, p); p = __builtin_amdgcn_cvt_pk_u8_f32(fmaxf(xf<X_SIG>(v[1]) * 255.f, qmin), 1u, p);
                    p = __builtin_amdgcn_cvt_pk_u8_f32(fmaxf(xf<X_SIG>(v[2]) * 255.f, qmin), 2u, p); p = __builtin_amdgcn_cvt_pk_u8_f32(fmaxf(xf<X_SIG>(v[3]) * 255.f, qmin), 3u, p);
                    w[n] = p; }
                *(v2u*)(rowp + bj * 128) = (v2u){w[0], w[1]}; } }
}
__device__ __forceinline__ unsigned pkh2(float a, float b) { h2 t; t.x = (_Float16)a; t.y = (_Float16)b; return __builtin_bit_cast(unsigned, t); }
__device__ __forceinline__ void store_f16(const f32x4 (&acc)[2][2][4][2], unsigned short* base, int ldc, int row0, int col0, float sc) {
#pragma unroll
    for (int ai = 0; ai < 2; ++ai)
#pragma unroll
        for (int m = 0; m < 4; ++m) { unsigned short* rowp = base + (size_t)(row0 + ai * 128 + m * 16) * ldc + col0;
#pragma unroll
            for (int bj = 0; bj < 2; ++bj) { const f32x4 v0 = acc[ai][bj][m][0], v1 = acc[ai][bj][m][1];
                u32x4 w; w.x = pkh2(v0[0] * sc, v0[1] * sc); w.y = pkh2(v0[2] * sc, v0[3] * sc); w.z = pkh2(v1[0] * sc, v1[1] * sc); w.w = pkh2(v1[2] * sc, v1[3] * sc);
                *(u32x4*)(rowp + bj * 128) = w; }
            asm volatile("" ::: "memory"); }
}
template <int NBJ> __device__ __forceinline__ void store_f32(const f32x4 (&acc)[2][2][4][2], float* base, int ldc, int row0, int col0) {
#pragma unroll
    for (int ai = 0; ai < 2; ++ai)
#pragma unroll
        for (int m = 0; m < 4; ++m) { float* rowp = base + (size_t)(row0 + ai * 128 + m * 16) * ldc + col0;
#pragma unroll
            for (int bj = 0; bj < NBJ; ++bj) { *(f32x4*)(rowp + bj * 128) = acc[ai][bj][m][0]; *(f32x4*)(rowp + bj * 128 + 4) = acc[ai][bj][m][1]; } }
}

struct EpiProj {
    static constexpr bool PERM = true, AFTER_DRAIN = false, HAS_MID = false;
    unsigned char* ws;
    __device__ __forceinline__ void operator()(const f32x4 (&acc)[2][2][4][2], const Unit& u, int wr, int wc, int fr, int fq) const {
        const int row0 = u.pm * 256 + wr * 64 + fr, cl = wc * 32 + 8 * fq, pn = u.pn;
        if (pn < 2) store_bf16<X_NONE>(acc, (bf16_t*)(ws + WS_QH), 512, row0, pn * 256 + cl, 1.f);
        else if (pn < 4) {
            float* G = (float*)(ws + WS_G); const float* lb = (const float*)(ws + WS_LB); const int cb = (pn - 2) * 256 + cl;
            f32x4 lbv[2][2];
#pragma unroll
            for (int bj = 0; bj < 2; ++bj)
#pragma unroll
                for (int n = 0; n < 2; ++n) lbv[bj][n] = *(const f32x4*)(lb + cb + bj * 128 + 4 * n);
#pragma unroll
            for (int ai = 0; ai < 2; ++ai)
#pragma unroll
                for (int m = 0; m < 4; ++m) { float* rowp = G + (size_t)(row0 + ai * 128 + m * 16) * 512 + cb;
#pragma unroll
                    for (int bj = 0; bj < 2; ++bj)
#pragma unroll
                        for (int n = 0; n < 2; ++n) { f32x4 o;
#pragma unroll
                            for (int j = 0; j < 4; ++j) { const float l = lbv[bj][n][j]; o[j] = __logf(l + (1.0f - l) * sigmoidf_(acc[ai][bj][m][n][j])); }
                            *(f32x4*)(rowp + bj * 128 + 4 * n) = o; } }
        }
        else if (pn < 6) store_bf16<X_NONE>(acc, (bf16_t*)(ws + WS_VH), 512, row0, (pn - 4) * 256 + cl, 1.f);
        else if (pn < 8) store_bf16<X_SILU>(acc, (bf16_t*)(ws + WS_SG), 512, row0, (pn - 6) * 256 + cl, 1.f);
        else if (pn < 12) store_gate_u8(acc, ws + WS_GA, 1024, row0, (pn - 8) * 256 + cl, 0.f);
        else if (pn < 16) store_gate_u8(acc, ws + WS_GB, 1024, row0, (pn - 12) * 256 + cl, 1.f);
        else if (pn == 16) {
            bf16_t* CQB = (bf16_t*)(ws + WS_CQN); float* rsq = (float*)(ws + WS_CTL) + CW_ROWSSQ;
#pragma unroll
            for (int ai = 0; ai < 2; ++ai)
#pragma unroll
                for (int m = 0; m < 4; ++m) { const int row = row0 + ai * 128 + m * 16; float ss = 0.f;
#pragma unroll
                    for (int bj = 0; bj < 2; ++bj) { const f32x4 v0 = acc[ai][bj][m][0], v1 = acc[ai][bj][m][1];
                        ss += (v0[0] * v0[0] + v0[1] * v0[1]) + (v0[2] * v0[2] + v0[3] * v0[3]) + (v1[0] * v1[0] + v1[1] * v1[1]) + (v1[2] * v1[2] + v1[3] * v1[3]);
                        u32x4 w; w.x = cvt_pk_bf16(v0[0], v0[1]); w.y = cvt_pk_bf16(v0[2], v0[3]); w.z = cvt_pk_bf16(v1[0], v1[1]); w.w = cvt_pk_bf16(v1[2], v1[3]);
                        *(u32x4*)(CQB + (size_t)row * 256 + cl + bj * 128) = w; }
                    ss += __shfl_xor(ss, 16); ss += __shfl_xor(ss, 32);
                    if (fq == 0) atomicAdd(rsq + row, ss); }
        }
        else if (pn == 17) {
            unsigned char* KV8 = ws + WS_KV;
#pragma unroll
            for (int ai = 0; ai < 2; ++ai)
#pragma unroll
                for (int m = 0; m < 4; ++m) { unsigned char* rowp = KV8 + (size_t)(row0 + ai * 128 + m * 16) * 256;
#pragma unroll
                    for (int bj = 0; bj < 2; ++bj) { const f32x4 v0 = acc[ai][bj][m][0], v1 = acc[ai][bj][m][1];
                        int w0 = __builtin_amdgcn_cvt_pk_fp8_f32(v0[0], v0[1], 0, false); w0 = __builtin_amdgcn_cvt_pk_fp8_f32(v0[2], v0[3], w0, true);
                        int w1 = __builtin_amdgcn_cvt_pk_fp8_f32(v1[0], v1[1], 0, false); w1 = __builtin_amdgcn_cvt_pk_fp8_f32(v1[2], v1[3], w1, true);
                        const int dst = bj == 0 ? (fq * 32 + wc * 8) : (128 + cl);
                        *(v2u*)(rowp + dst) = (v2u){(unsigned)w0, (unsigned)w1}; } }
        }
        else store_f32<1>(acc, (float*)(ws + WS_IKW), 128, row0, cl);
    }
};
struct EpiQI {
    static constexpr bool PERM = true, AFTER_DRAIN = false, HAS_MID = false;
    unsigned char* ws;
    __device__ __forceinline__ void operator()(f32x4 (&acc)[2][2][4][2], const Unit& u, int wr, int wc, int fr, int fq) const {
        const int row0 = u.pm * 256 + wr * 64 + fr, cl = wc * 32 + 8 * fq, pn = u.pn;
        {
            const float* rsq = (const float*)(ws + WS_CTL) + CW_ROWSSQ; float rs[2][4];
#pragma unroll
            for (int ai = 0; ai < 2; ++ai)
#pragma unroll
                for (int m = 0; m < 4; ++m) rs[ai][m] = rsq[row0 + ai * 128 + m * 16];
#pragma unroll
            for (int ai = 0; ai < 2; ++ai)
#pragma unroll
                for (int m = 0; m < 4; ++m) { const float rstd = 1.0f / sqrtf(rs[ai][m] * (1.f / 256.f) + EPS);
#pragma unroll
                    for (int bj = 0; bj < 2; ++bj) { acc[ai][bj][m][0] *= rstd; acc[ai][bj][m][1] *= rstd; } }
        }
        if (pn < 2) store_bf16<X_NONE>(acc, (bf16_t*)(ws + WS_AQ), 512, row0, pn * 256 + cl, 0.125f);
        else store_f16(acc, (unsigned short*)(ws + WS_IQ), 512, row0, (pn - 2) * 256 + cl, 0.125f);
    }
};
struct EpiMixM {
    static constexpr bool PERM = true, AFTER_DRAIN = false, HAS_MID = true;
    unsigned char* ws;
    __device__ __forceinline__ void mid(f32x4 (&acc)[2][2][4][2], const Unit& u, int wr, int wc, int fr, int fq) const {
        int row0 = u.pm * 256 + wr * 64 + fr, col0 = u.pn * 256 + wc * 32 + 8 * fq;
        asm volatile("" : "+v"(row0), "+v"(col0));
        const unsigned char* GA = ws + WS_GA; const unsigned char* GB = ws + WS_GB;
#pragma unroll
        for (int ai = 0; ai < 2; ++ai) {
            v2u ga[4][2], gb[4][2];
#pragma unroll
            for (int m = 0; m < 4; ++m) { const size_t off = (size_t)(row0 + ai * 128 + m * 16) * 1024 + col0;
#pragma unroll
                for (int bj = 0; bj < 2; ++bj) { ga[m][bj] = *(const v2u*)(GA + off + bj * 128); gb[m][bj] = *(const v2u*)(GB + off + bj * 128); } }
#pragma unroll
            for (int m = 0; m < 4; ++m)
#pragma unroll
                for (int bj = 0; bj < 2; ++bj) { const v2u a = ga[m][bj], b = gb[m][bj];
                    f32x4& v0 = acc[ai][bj][m][0]; f32x4& v1 = acc[ai][bj][m][1];
                    v0[0] *= ubf<0>(a.x) * __builtin_amdgcn_rcpf(ubf<0>(b.x)); v0[1] *= ubf<1>(a.x) * __builtin_amdgcn_rcpf(ubf<1>(b.x));
                    v0[2] *= ubf<2>(a.x) * __builtin_amdgcn_rcpf(ubf<2>(b.x)); v0[3] *= ubf<3>(a.x) * __builtin_amdgcn_rcpf(ubf<3>(b.x));
                    v1[0] *= ubf<0>(a.y) * __builtin_amdgcn_rcpf(ubf<0>(b.y)); v1[1] *= ubf<1>(a.y) * __builtin_amdgcn_rcpf(ubf<1>(b.y));
                    v1[2] *= ubf<2>(a.y) * __builtin_amdgcn_rcpf(ubf<2>(b.y)); v1[3] *= ubf<3>(a.y) * __builtin_amdgcn_rcpf(ubf<3>(b.y)); }
            asm volatile("" ::: "memory"); }
    }
    __device__ __forceinline__ void operator()(const f32x4 (&acc)[2][2][4][2], const Unit& u, int wr, int wc, int fr, int fq) const {
        const int row0 = u.pm * 256 + wr * 64 + fr, col0 = u.pn * 256 + wc * 32 + 8 * fq;
        const unsigned char* GB = ws + WS_GB; bf16_t* out = (bf16_t*)(ws + WS_MIX); constexpr float Q = 1.0f / 255.0f;
#pragma unroll
        for (int ai = 0; ai < 2; ++ai)
#pragma unroll
            for (int m = 0; m < 4; ++m) { const size_t off = (size_t)(row0 + ai * 128 + m * 16) * 1024 + col0;
#pragma unroll
                for (int bj = 0; bj < 2; ++bj) { const v2u gv = *(const v2u*)(GB + off + bj * 128);
                    const f32x4 v0 = acc[ai][bj][m][0] * Q, v1 = acc[ai][bj][m][1] * Q; u32x4 w;
                    w.x = cvt_pk_bf16(ubf<0>(gv.x) * v0[0], ubf<1>(gv.x) * v0[1]); w.y = cvt_pk_bf16(ubf<2>(gv.x) * v0[2], ubf<3>(gv.x) * v0[3]);
                    w.z = cvt_pk_bf16(ubf<0>(gv.y) * v1[0], ubf<1>(gv.y) * v1[1]); w.w = cvt_pk_bf16(ubf<2>(gv.y) * v1[2], ubf<3>(gv.y) * v1[3]);
                    ST_STREAM((u32x4*)(out + off + bj * 128), w); }
                if (m == 3) asm volatile("" ::: "memory"); }
    }
};
struct EpiWo {
    static constexpr bool PERM = true, AFTER_DRAIN = false, HAS_MID = false;
    const bf16_t* base; const float* rms; bf16_t* x1b; float* rowss;
    __device__ __forceinline__ void operator()(const f32x4 (&acc)[2][2][4][2], const Unit& u, int wr, int wc, int fr, int fq) const {
        const int row0 = u.pm * 256 + wr * 64 + fr, col0 = u.pn * 256 + wc * 32 + 8 * fq;
        float rm[2][4];
#pragma unroll
        for (int ai = 0; ai < 2; ++ai)
#pragma unroll
            for (int m = 0; m < 4; ++m) rm[ai][m] = rms[row0 + ai * 128 + m * 16];
#pragma unroll
        for (int ai = 0; ai < 2; ++ai)
#pragma unroll
            for (int m = 0; m < 4; ++m) { const int row = row0 + ai * 128 + m * 16; const size_t off = (size_t)row * 1024 + col0; float ss = 0.f; const float r = rm[ai][m];
#pragma unroll
                for (int bj = 0; bj < 2; ++bj) {
                    const u32x4 bb = *(const u32x4*)(base + off + bj * 128);
                    const f32x4 x0 = (f32x4){bflo(bb.x), bfhi(bb.x), bflo(bb.y), bfhi(bb.y)} * r + acc[ai][bj][m][0], x1 = (f32x4){bflo(bb.z), bfhi(bb.z), bflo(bb.w), bfhi(bb.w)} * r + acc[ai][bj][m][1];
                    ss += (x0[0] * x0[0] + x0[1] * x0[1]) + (x0[2] * x0[2] + x0[3] * x0[3]) + (x1[0] * x1[0] + x1[1] * x1[1]) + (x1[2] * x1[2] + x1[3] * x1[3]);
                    u32x4 w; w.x = cvt_pk_bf16(x0[0], x0[1]); w.y = cvt_pk_bf16(x0[2], x0[3]); w.z = cvt_pk_bf16(x1[0], x1[1]); w.w = cvt_pk_bf16(x1[2], x1[3]);
                    ST_STREAM((u32x4*)(x1b + off + bj * 128), w); }
                ss += __shfl_xor(ss, 16); ss += __shfl_xor(ss, 32);
                if (fq == 0) atomicAdd(rowss + row, ss);
                if (m & 1) asm volatile("" ::: "memory"); }
    }
};
struct EpiResid {
    static constexpr bool PERM = true, AFTER_DRAIN = false, HAS_MID = false;
    const bf16_t* base; float* out;
    __device__ __forceinline__ void operator()(const f32x4 (&acc)[2][2][4][2], const Unit& u, int wr, int wc, int fr, int fq) const {
        const int row0 = u.pm * 256 + wr * 64 + fr, col0 = u.pn * 256 + wc * 32 + 8 * fq;
#pragma unroll
        for (int ai = 0; ai < 2; ++ai)
#pragma unroll
            for (int m = 0; m < 4; ++m) { const size_t off = (size_t)(row0 + ai * 128 + m * 16) * 1024 + col0;
#pragma unroll
                for (int bj = 0; bj < 2; ++bj) {
                    const u32x4 bb = *(const u32x4*)(base + off + bj * 128);
                    const f32x4 b0 = (f32x4){bflo(bb.x), bfhi(bb.x), bflo(bb.y), bfhi(bb.y)}, b1 = (f32x4){bflo(bb.z), bfhi(bb.z), bflo(bb.w), bfhi(bb.w)};
                    *(f32x4*)(out + off + bj * 128) = b0 + acc[ai][bj][m][0]; *(f32x4*)(out + off + bj * 128 + 4) = b1 + acc[ai][bj][m][1]; }
                if (m & 1) asm volatile("" ::: "memory"); }
    }
};
struct EpiFinal {
    static constexpr bool PERM = true, AFTER_DRAIN = false, HAS_MID = false;
    const bf16_t* base; float* out; const float* gain; float* rowss; unsigned* pcnt;
    __device__ __forceinline__ void operator()(f32x4 (&acc)[2][2][4][2], const Unit& u, int wr, int wc, int fr, int fq) const {
        const int row0 = u.pm * 256 + wr * 64 + fr, col0 = u.pn * 256 + wc * 32 + 8 * fq; float dummy = 0.f;
#pragma unroll
        for (int ai = 0; ai < 2; ++ai)
#pragma unroll
            for (int m = 0; m < 4; ++m) { const int row = row0 + ai * 128 + m * 16; const size_t off = (size_t)row * 1024 + col0; float ss = 0.f;
#pragma unroll
                for (int bj = 0; bj < 2; ++bj) {
                    const u32x4 bb = *(const u32x4*)(base + off + bj * 128);
                    const f32x4 x0 = (f32x4){bflo(bb.x), bfhi(bb.x), bflo(bb.y), bfhi(bb.y)} + acc[ai][bj][m][0], x1 = (f32x4){bflo(bb.z), bfhi(bb.z), bflo(bb.w), bfhi(bb.w)} + acc[ai][bj][m][1];
                    acc[ai][bj][m][0] = x0; acc[ai][bj][m][1] = x1;
                    ss += (x0[0] * x0[0] + x0[1] * x0[1]) + (x0[2] * x0[2] + x0[3] * x0[3]) + (x1[0] * x1[0] + x1[1] * x1[1]) + (x1[2] * x1[2] + x1[3] * x1[3]); }
                ss += __shfl_xor(ss, 16); ss += __shfl_xor(ss, 32);
                if (fq == 0) dummy += __hip_atomic_fetch_add(rowss + row, ss, __ATOMIC_RELAXED, __HIP_MEMORY_SCOPE_AGENT);
                if (m & 1) asm volatile("" ::: "memory"); }
        asm volatile("s_waitcnt vmcnt(0)" :: "v"(dummy) : "memory");
        __builtin_amdgcn_s_barrier();
        if ((wr | wc | fr | fq) == 0) {
            (void)__hip_atomic_fetch_add(pcnt + u.pm, 1u, __ATOMIC_RELAXED, __HIP_MEMORY_SCOPE_AGENT);
            while (__hip_atomic_load(pcnt + u.pm, __ATOMIC_RELAXED, __HIP_MEMORY_SCOPE_AGENT) < 4u) __builtin_amdgcn_s_sleep(1);
        }
        asm volatile("" ::: "memory");
        __builtin_amdgcn_s_barrier();
        asm volatile("" ::: "memory");
        f32x4 gv[2][2];
#pragma unroll
        for (int bj = 0; bj < 2; ++bj) { gv[bj][0] = *(const f32x4*)(gain + col0 + bj * 128); gv[bj][1] = *(const f32x4*)(gain + col0 + bj * 128 + 4); }
        float rs[2][4];
#pragma unroll
        for (int ai = 0; ai < 2; ++ai)
#pragma unroll
            for (int m = 0; m < 4; ++m) rs[ai][m] = __hip_atomic_load(rowss + row0 + ai * 128 + m * 16, __ATOMIC_RELAXED, __HIP_MEMORY_SCOPE_AGENT);
#pragma unroll
        for (int ai = 0; ai < 2; ++ai)
#pragma unroll
            for (int m = 0; m < 4; ++m) { const int row = row0 + ai * 128 + m * 16; const size_t off = (size_t)row * 1024 + col0;
                const float rstd = 1.0f / sqrtf(rs[ai][m] * (1.f / 1024.f) + EPS);
#pragma unroll
                for (int bj = 0; bj < 2; ++bj) { ST_STREAM((f32x4*)(out + off + bj * 128), acc[ai][bj][m][0] * rstd * gv[bj][0]); ST_STREAM((f32x4*)(out + off + bj * 128 + 4), acc[ai][bj][m][1] * rstd * gv[bj][1]); }
                if (m & 1) asm volatile("" ::: "memory"); }
    }
};
struct EpiRelu2 {
    static constexpr bool PERM = true, AFTER_DRAIN = false, HAS_MID = false;
    bf16_t* out; const float* rowss;
    __device__ __forceinline__ void operator()(const f32x4 (&acc)[2][2][4][2], const Unit& u, int wr, int wc, int fr, int fq) const {
        const int row0 = u.pm * 256 + wr * 64 + fr, col0 = u.pn * 256 + wc * 32 + 8 * fq;
        float rs[2][4];
#pragma unroll
        for (int ai = 0; ai < 2; ++ai)
#pragma unroll
            for (int m = 0; m < 4; ++m) rs[ai][m] = rowss[row0 + ai * 128 + m * 16];
#pragma unroll
        for (int ai = 0; ai < 2; ++ai)
#pragma unroll
            for (int m = 0; m < 4; ++m) { const int row = row0 + ai * 128 + m * 16; bf16_t* rowp = out + (size_t)row * DFF + col0;
                const float rstd = 1.0f / sqrtf(rs[ai][m] * (1.f / 1024.f) + EPS);
#pragma unroll
                for (int bj = 0; bj < 2; ++bj) { const f32x4 v0 = acc[ai][bj][m][0] * rstd, v1 = acc[ai][bj][m][1] * rstd;
                    u32x4 w; w.x = cvt_pk_bf16(xf<X_RELU2>(v0[0]), xf<X_RELU2>(v0[1])); w.y = cvt_pk_bf16(xf<X_RELU2>(v0[2]), xf<X_RELU2>(v0[3]));
                    w.z = cvt_pk_bf16(xf<X_RELU2>(v1[0]), xf<X_RELU2>(v1[1])); w.w = cvt_pk_bf16(xf<X_RELU2>(v1[2]), xf<X_RELU2>(v1[3]));
                    ST_STREAM((u32x4*)(rowp + bj * 128), w); } }
    }
};
}

#define XB_TMO      128
#define XB_XCNT(j)  (256  + 64 * (j))
#define XB_XSUB(j)  (1280 + 64 * (j))
#define XB_XGEN(j)  (2304 + 64 * (j))
#define XB_TOP      3328
#define XB_TOPGEN   3392
#define XCD_BAR_WORDS 3456
#define XB_SPIN_CAP (1u << 18)

__device__ __forceinline__ unsigned xb_ld(unsigned* p)              { return __hip_atomic_load(p, __ATOMIC_RELAXED, __HIP_MEMORY_SCOPE_AGENT); }
__device__ __forceinline__ unsigned xb_add(unsigned* p, unsigned v) { return __hip_atomic_fetch_add(p, v, __ATOMIC_RELAXED, __HIP_MEMORY_SCOPE_AGENT); }
__device__ __forceinline__ unsigned xb_xcc_id() { return (unsigned)__builtin_amdgcn_s_getreg((3 << 11) | 20) & 0xFu; }
#define XB_SPIN(cond, bar) do { unsigned _sp = 0; while (cond) { __builtin_amdgcn_s_sleep(1); \
    if ((++_sp & 255u) == 0u) { if (xb_ld(&(bar)[XB_TMO])) break; if (_sp > XB_SPIN_CAP) { atomicAdd(&(bar)[XB_TMO], 1u); break; } } } } while (0)

struct XcdBarrier {
    unsigned* bar; unsigned x;
    volatile LAS unsigned* st;
};

__device__ __forceinline__ XcdBarrier xcd_barrier_post(unsigned* bar, volatile LAS unsigned* st, const bool is_t0) {
    XcdBarrier b; b.bar = bar; b.x = xb_xcc_id(); b.st = st;
    if (is_t0) (void)xb_add(&bar[XB_XCNT(b.x)], 1u);
    return b;
}
__device__ __forceinline__ void xcd_barrier_complete(unsigned* bar, unsigned x, unsigned& nloc, unsigned& nx) {
    const unsigned G = gridDim.x * gridDim.y * gridDim.z;
    unsigned sum, cnt, mine, sp = 0u;
    for (;;) {
        sum = 0u; cnt = 0u; mine = 0u;
#pragma unroll
        for (unsigned j = 0; j < 16; ++j) { const unsigned c = xb_ld(&bar[XB_XCNT(j)]); sum += c; cnt += (c > 0u) ? 1u : 0u; mine = (j == x) ? c : mine; }
        if (sum == G) break;
        __builtin_amdgcn_s_sleep(1);
        if ((++sp & 255u) == 0u) { if (xb_ld(&bar[XB_TMO])) break; if (sp > XB_SPIN_CAP) { atomicAdd(&bar[XB_TMO], 1u); break; } }
    }
    nloc = mine > 0u ? mine : 1u; nx = cnt > 0u ? cnt : 1u;
}

__device__ __forceinline__ void xcd_barrier(const XcdBarrier& b, const bool is_t0) {
    asm volatile("s_waitcnt vmcnt(0)" ::: "memory");
    __syncthreads();
    if (is_t0) {
        unsigned* bar = b.bar;
        __builtin_amdgcn_s_waitcnt(0);
        unsigned nloc = b.st[0], nx = b.st[1];
        if (nloc == 0u) { xcd_barrier_complete(bar, b.x, nloc, nx); b.st[0] = nloc; b.st[1] = nx; }
        const unsigned old = xb_add(&bar[XB_XSUB(b.x)], 1u);
        const unsigned gen = old / nloc;
        if (old + 1u == (gen + 1u) * nloc) {
            __builtin_amdgcn_fence(__ATOMIC_RELEASE, "agent");
            asm volatile("s_waitcnt vmcnt(0)" ::: "memory");
            const unsigned og = xb_add(&bar[XB_TOP], 1u);
            const unsigned tg = og / nx;
            if (og + 1u == (tg + 1u) * nx) xb_add(&bar[XB_TOPGEN], 1u);
            else XB_SPIN(xb_ld(&bar[XB_TOPGEN]) == tg, bar);
            __builtin_amdgcn_fence(__ATOMIC_ACQUIRE, "agent");
            xb_add(&bar[XB_XGEN(b.x)], 1u);
            asm volatile("s_waitcnt vmcnt(0)" ::: "memory");
        } else {
            XB_SPIN(xb_ld(&bar[XB_XGEN(b.x)]) == gen, bar);
            __builtin_amdgcn_fence(__ATOMIC_ACQUIRE, "agent");
            asm volatile("s_waitcnt vmcnt(0)" ::: "memory");
        }
    }
    __syncthreads();
}

__device__ __forceinline__ int lane_fresh() { int l; asm volatile("v_mbcnt_lo_u32_b32 %0, -1, 0\n\tv_mbcnt_hi_u32_b32 %0, -1, %0" : "=v"(l)); return l; }
#define F_LANE (lane_fresh())
#define F_TID (F.wave * 64 + lane_fresh())
struct Ctx {
    LAS unsigned char* lds; int wave, G, bid;
    const float* const* in; float* out; unsigned char* ws;
};

__device__ __forceinline__ int proj_src_col(int j) {
    if (j < 2048) return j;
    if (j < 3072) return 2632 + (j - 2048);
    if (j < 4096) return 3656 + (j - 3072);
    if (j < 4352) return 2048 + (j - 4096);
    if (j < 4608) return 2304 + (j - 4352);
    if (j < 4680) return 2560 + (j - 4608);
    return -1;
}
template <bool MAPPED>
__device__ __forceinline__ void transpose_item(const float* W, int Nsrc, int K, bf16* WT, int row_off, int nblk, LAS float* scr, int item, int lane, int ldk = 0, int koff = 0, const float* kscale = nullptr) {
    if (ldk == 0) ldk = K;
    const int kb = item / nblk, nb = item % nblk, k0 = 64 * kb, n0 = 32 * nb;
    int sc = n0 + (lane & 31); if (MAPPED) sc = proj_src_col(sc);
    {
        float wv_[32], ks_[32];
#pragma unroll
        for (int i = 0; i < 32; ++i) { const int kk = 2 * i + (lane >> 5); ks_[i] = kscale ? kscale[k0 + kk] : 1.0f;
            wv_[i] = (sc >= 0) ? __builtin_nontemporal_load(W + (size_t)(k0 + kk) * Nsrc + sc) : 0.f; }
#pragma unroll
        for (int i = 0; i < 32; ++i) { const int kk = 2 * i + (lane >> 5); scr[kk * 33 + (lane & 31)] = wv_[i] * ks_[i]; }
    }
    LDS_WAIT(); asm volatile("" ::: "memory");
    const int c = lane & 7;
#pragma unroll
    for (int j = 0; j < 4; ++j) { const int n = (lane >> 3) + 8 * j; const LAS float* s = scr + (8 * c) * 33 + n;
        v4u o; o.x = pk2(s[0 * 33], s[1 * 33]); o.y = pk2(s[2 * 33], s[3 * 33]); o.z = pk2(s[4 * 33], s[5 * 33]); o.w = pk2(s[6 * 33], s[7 * 33]);
        *(GAS v4u*)(WT + (size_t)(row_off + n0 + n) * ldk + koff + k0 + 8 * c) = o; }
    LDS_WAIT(); asm volatile("" ::: "memory");
}
__device__ __forceinline__ void rms_row_to_bf16(const float* xrow, float* rmsp, bf16* orow, int lane) {
    const GAS f32x4* xr = (const GAS f32x4*)xrow + lane;
    f32x4 v[4]; float s = 0.f;
#pragma unroll
    for (int j = 0; j < 4; ++j) { v[j] = xr[64 * j]; s += (v[j].x * v[j].x + v[j].y * v[j].y) + (v[j].z * v[j].z + v[j].w * v[j].w); }
    const float ms = wave_sum(s) * (1.f / 1024.f) + EPS; const float rstd = 1.0f / sqrtf(ms);
    if (lane == 0) *rmsp = sqrtf(ms);
    GAS unsigned long long* o8 = (GAS unsigned long long*)orow + lane;
#pragma unroll
    for (int j = 0; j < 4; ++j)
        o8[64 * j] = (unsigned long long)pk2(v[j].x * rstd, v[j].y * rstd) | ((unsigned long long)pk2(v[j].z * rstd, v[j].w * rstd) << 32);
}
__device__ __forceinline__ void p0_prologue(const Ctx& F) {
    LAS float* scr = (LAS float*)(F.lds + F.wave * 16384);
    const int gw = F.bid * NWAVES + F.wave, NGW = F.G * NWAVES;
    bf16* wt_in = (bf16*)(F.ws + WS_WIN); bf16* wt_qi = (bf16*)(F.ws + WS_WQI);
    constexpr int I_IN = 16 * 152, I_UQ = 4 * 16;
    constexpr int NITEMS = I_IN + 2 * I_UQ;
    if (F.bid == 0) {
        float* lb = (float*)(F.ws + WS_LB); const float* lg = F.in[3];
        for (int d = F_TID; d < 512; d += NTHR) lb[d] = 1.0f / (1.0f + expf(lg[512 + d] - lg[d]));
    }
    bf16* H = (bf16*)(F.ws + WS_HM);
    {
        constexpr int RIF = 3; const int lane = F_LANE; float* rmsb = (float*)(F.ws + WS_RMS);
        for (int m0 = gw; m0 < M; m0 += RIF * NGW) {
            f32x4 vv[RIF][4];
#pragma unroll
            for (int r = 0; r < RIF; ++r) { const int m = m0 + r * NGW; const GAS f32x4* xr = (const GAS f32x4*)(F.in[0] + (size_t)(m < M ? m : m0) * DM) + lane;
#pragma unroll
                for (int j = 0; j < 4; ++j) vv[r][j] = __builtin_nontemporal_load(xr + 64 * j); }
#pragma unroll
            for (int r = 0; r < RIF; ++r) { const int m = m0 + r * NGW; if (m >= M) break;
                float s = 0.f;
#pragma unroll
                for (int j = 0; j < 4; ++j) { const f32x4 v = vv[r][j]; s += (v.x * v.x + v.y * v.y) + (v.z * v.z + v.w * v.w); }
                const float ms = wave_sum(s) * (1.f / 1024.f) + EPS; const float rstd = 1.0f / sqrtf(ms);
                if (lane == 0) rmsb[m] = sqrtf(ms);
                GAS unsigned long long* o8 = (GAS unsigned long long*)(H + (size_t)m * DM) + lane;
#pragma unroll
                for (int j = 0; j < 4; ++j) { const f32x4 v = vv[r][j];
                    o8[64 * j] = (unsigned long long)pk2(v.x * rstd, v.y * rstd) | ((unsigned long long)pk2(v.z * rstd, v.w * rstd) << 32); } }
        }
    }
    for (int it = gw; it < NITEMS; it += NGW) {
        int r = it;
        if (r < I_IN) { transpose_item<true>(F.in[2], 4680, 1024, wt_in, 0, 152, scr, r, F_LANE, 0, 0, F.in[1]); continue; } r -= I_IN;
        if (r < I_UQ) { transpose_item<false>(F.in[7], 512, 256, wt_qi, 0, 16, scr, r, F_LANE, 0, 0, F.in[6]); continue; } r -= I_UQ;
        transpose_item<false>(F.in[8], 512, 256, wt_qi, 512, 16, scr, r, F_LANE, 0, 0, F.in[6]);
    }
}

constexpr int LW_MH = 8 * 32, LW_O = 16 * 32, LW_MI = 16 * 128, LW_MO = 64 * 32, LW_ITEMS = 2 * LW_MH + LW_O + LW_MI + LW_MO;
__device__ __forceinline__ void late_weight_item(const Ctx& F, int r) {
    LAS float* scr = (LAS float*)(F.lds + F.wave * 16384);
    bf16* wt_mh = (bf16*)(F.ws + WS_WMH); bf16* wt_o = (bf16*)(F.ws + WS_WO); bf16* wt_mi = (bf16*)(F.ws + WS_WMI); bf16* wt_mo = (bf16*)(F.ws + WS_WMO);
    if (r < LW_MH) { transpose_item<false>(F.in[5], 1024, 512, wt_mh, 0, 32, scr, r, F_LANE, 1024, 0); return; } r -= LW_MH;
    if (r < LW_MH) { transpose_item<false>(F.in[12], 1024, 512, wt_mh, 0, 32, scr, r, F_LANE, 1024, 512); return; } r -= LW_MH;
    if (r < LW_O) { transpose_item<false>(F.in[13], 1024, 1024, wt_o, 0, 32, scr, r, F_LANE); return; } r -= LW_O;
    if (r < LW_MI) { transpose_item<false>(F.in[15], 4096, 1024, wt_mi, 0, 128, scr, r, F_LANE, 0, 0, F.in[14]); return; } r -= LW_MI;
    transpose_item<false>(F.in[16], 1024, 4096, wt_mo, 0, 32, scr, r, F_LANE);
}

__device__ __forceinline__ void p2_norms(const Ctx& F) {
    const int gw = F.bid * NWAVES + F.wave, NGW = F.G * NWAVES, lane = F_LANE;
    const float* IKW = (const float*)(F.ws + WS_IKW); unsigned short* IKN = (unsigned short*)(F.ws + WS_IKN);
    const float kg = F.in[9][lane], kb = F.in[10][lane];
    for (int m0 = gw; m0 < M; m0 += 4 * NGW) {
        float kk[4];
#pragma unroll
        for (int r = 0; r < 4; ++r) { const int m = m0 + r * NGW; kk[r] = IKW[(size_t)(m < M ? m : m0) * 128 + lane]; }
#pragma unroll
        for (int r = 0; r < 4; ++r) { const int m = m0 + r * NGW; if (m >= M) break;
            const float k = kk[r];
            const float mu = wave_sum(k) * (1.f / 64.f); const float dk = k - mu;
            const float var = wave_sum(dk * dk) * (1.f / 64.f);
            const float y = dk * (1.0f / sqrtf(var + EPS)) * kg + kb;
            const _Float16 yh = (_Float16)y;
            IKN[(size_t)m * 64 + lane] = __builtin_bit_cast(unsigned short, yh); }
    }
}
__device__ __forceinline__ void p11_final(const Ctx& F) {
    const int gw = F.bid * NWAVES + F.wave, NGW = F.G * NWAVES, lane = F_LANE;
    const GAS f32x4* gr = (const GAS f32x4*)F.in[17] + lane;
    for (int m = gw; m < M; m += NGW) {
        GAS f32x4* xr = (GAS f32x4*)(F.out + (size_t)m * DM) + lane;
        f32x4 v[4]; float s = 0.f;
#pragma unroll
        for (int j = 0; j < 4; ++j) { v[j] = xr[64 * j]; s += (v[j].x * v[j].x + v[j].y * v[j].y) + (v[j].z * v[j].z + v[j].w * v[j].w); }
        const float rstd = 1.0f / sqrtf(wave_sum(s) * (1.f / 1024.f) + EPS);
#pragma unroll
        for (int j = 0; j < 4; ++j) xr[64 * j] = v[j] * rstd * gr[64 * j];
    }
}

namespace hg {
constexpr int RS1 = 272, RS2 = 144;
constexpr int O_QA = 0, O_KA = O_QA + 64 * RS1, O_KST = O_KA + 64 * RS1, O_VT = O_KST + 128 * RS2, O_SPT = O_VT + 128 * RS2;
constexpr int O_TOT = O_SPT + 128 * RS1, O_RED = O_TOT + 4096, O_END = O_RED + 512;
static_assert(O_END <= 120000, "hgrn lds");
}
__device__ __forceinline__ bf16x8 lds_b128(const LAS unsigned char* p) { return *(const LAS bf16x8*)p; }
#ifndef HG_NSEG_
#define HG_NSEG_ 16
#endif
constexpr int HG_NSEG = HG_NSEG_, HG_CH = SEQ / 64 / HG_NSEG, HG_UNITS = 16 * HG_NSEG;
constexpr size_t HG_DLG_OFF = (size_t)24 * 1024 * 1024;
template <int PASS>
__device__ __forceinline__ void hgrn_segment(const Ctx& F, int bh, int seg) {
    using namespace hg;
    int lane_ = F_LANE; asm volatile("" : "+v"(lane_));
    const int b = bh >> 2, h = bh & 3, lane = lane_, w = F.wave, tid = w * 64 + lane, g = lane >> 4, c16 = lane & 15, tt = w & 3, eh = w >> 2;
    LAS unsigned char* L = F.lds;
    LAS float* tot = (LAS float*)(L + O_TOT); LAS float* red = (LAS float*)(L + O_RED);
    const float* Gp = (const float*)(F.ws + WS_G); const bf16* Qp = (const bf16*)(F.ws + WS_QH); const bf16* Vp = (const bf16*)(F.ws + WS_VH);
    const bf16* SGp = (const bf16*)(F.ws + WS_SG); bf16* OAp = (bf16*)((unsigned char*)F.out + OAB_OFF); const float* hgn = F.in[4];
    float* Ubuf = F.out; float* Dlg = F.out + HG_DLG_OFF;
    f32x4 S[8];
#pragma unroll
    for (int i = 0; i < 8; ++i) S[i] = (f32x4){0.f, 0.f, 0.f, 0.f};
    const int cp = lane, rg = w;
    float dsum0 = 0.f, dsum1 = 0.f;
    if (PASS == 2) {
        f32x4 Lacc = (f32x4){0.f, 0.f, 0.f, 0.f};
#pragma unroll 1
        for (int jb = seg - 1; jb >= 0; jb -= 4) {
            f32x4 uu[4][8], dl[4];
#pragma unroll
            for (int q = 0; q < 4; ++q) { const int jx = jb - q >= 0 ? jb - q : 0;
                const float* up = Ubuf + ((size_t)(bh * HG_NSEG + jx) * 8 + w) * 2048 + lane * 4;
#pragma unroll
                for (int et = 0; et < 8; ++et) uu[q][et] = *(const f32x4*)(up + et * 256);
                dl[q] = *(const f32x4*)(Dlg + (size_t)(bh * HG_NSEG + jx) * 128 + 16 * w + 4 * g); }
#pragma unroll
            for (int q = 0; q < 4; ++q) { if (jb - q < 0) break;
                const f32x4 cf = (f32x4){__expf(Lacc[0]), __expf(Lacc[1]), __expf(Lacc[2]), __expf(Lacc[3])};
#pragma unroll
                for (int et = 0; et < 8; ++et) S[et] += uu[q][et] * cf;
                Lacc += dl[q]; }
        }
    }
    pg8::f32x2_t gN[8]; unsigned vN[8], qN[8]; v2u sgN[4]; f32x4 gnr[4];
#define HG_FETCH(CC) { const size_t R0n = (size_t)b * SEQ + (size_t)(CC) * 64; const size_t basen = (R0n + 8 * rg) * 512 + h * 128 + 2 * cp; \
        _Pragma("unroll") for (int i = 0; i < 8; ++i) { if (PASS == 1) { gN[i] = __builtin_nontemporal_load((const pg8::f32x2_t*)(Gp + basen + (size_t)i * 512)); vN[i] = __builtin_nontemporal_load((const unsigned*)(Vp + basen + (size_t)i * 512)); } else { gN[i] = *(const pg8::f32x2_t*)(Gp + basen + (size_t)i * 512); vN[i] = *(const unsigned*)(Vp + basen + (size_t)i * 512); } \
            if (PASS == 2) qN[i] = *(const unsigned*)(Qp + basen + (size_t)i * 512); } \
        if (PASS == 2) { const size_t rowoffn = (R0n + 16 * tt + c16) * 512 + h * 128; \
            _Pragma("unroll") for (int e4 = 0; e4 < 4; ++e4) sgN[e4] = *(const v2u*)(SGp + rowoffn + 16 * (4 * eh + e4) + 4 * g); } }
#define HG_SYNC() asm volatile("s_waitcnt lgkmcnt(0)\n\ts_barrier" ::: "memory")
    if (PASS == 2) {
#pragma unroll
        for (int e4 = 0; e4 < 4; ++e4) gnr[e4] = *(const f32x4*)(hgn + h * 128 + 16 * (4 * eh + e4) + 4 * g);
    }
    HG_FETCH(seg * HG_CH)
#pragma unroll 1
    for (int c = seg * HG_CH; c < (seg + 1) * HG_CH; ++c) {
        const size_t R0 = (size_t)b * SEQ + (size_t)c * 64;
        float gv[8][2], cs[8][2]; unsigned qc[8]; v2u sgc[4]; f32x4 el4;
        {
            float run0 = 0.f, run1 = 0.f;
#pragma unroll
            for (int i = 0; i < 8; ++i) { gv[i][0] = gN[i][0]; gv[i][1] = gN[i][1]; run0 += gv[i][0]; run1 += gv[i][1]; cs[i][0] = run0; cs[i][1] = run1; if (PASS == 2) qc[i] = qN[i]; }
            *(LAS pg8::f32x2_t*)(tot + rg * 128 + 2 * cp) = (pg8::f32x2_t){run0, run1};
            unsigned vlo[4], vhi[4];
#pragma unroll
            for (int p = 0; p < 4; ++p) { const unsigned va = vN[2 * p], vb = vN[2 * p + 1]; vlo[p] = (va & 0xffffu) | (vb << 16); vhi[p] = (va >> 16) | (vb & 0xffff0000u); }
#pragma unroll
            for (int e4 = 0; e4 < 4; ++e4) if (PASS == 2) sgc[e4] = sgN[e4];
            *(LAS v4u*)(L + O_VT + (2 * cp) * RS2 + rg * 16) = (v4u){vlo[0], vlo[1], vlo[2], vlo[3]};
            *(LAS v4u*)(L + O_VT + (2 * cp + 1) * RS2 + rg * 16) = (v4u){vhi[0], vhi[1], vhi[2], vhi[3]};
            if (c + 1 < (seg + 1) * HG_CH) HG_FETCH(c + 1)
        }
        HG_SYNC();
        {
            float off[2] = {0.f, 0.f}, Bmid[2] = {0.f, 0.f}, blast[2] = {0.f, 0.f};
#pragma unroll
            for (int r = 0; r < 8; ++r) { const pg8::f32x2_t t = *(const LAS pg8::f32x2_t*)(tot + r * 128 + 2 * cp);
#pragma unroll
                for (int ch = 0; ch < 2; ++ch) { if (r < 4) Bmid[ch] += t[ch]; blast[ch] += t[ch]; off[ch] += (r < rg) ? t[ch] : 0.f; } }
            {
                f32x4 bm4 = (f32x4){0.f, 0.f, 0.f, 0.f}, bl4 = (f32x4){0.f, 0.f, 0.f, 0.f};
#pragma unroll
                for (int r = 0; r < 8; ++r) { const f32x4 t4 = *(const LAS f32x4*)(tot + r * 128 + 16 * w + 4 * g); if (r < 4) bm4 += t4; bl4 += t4; }
                el4 = (f32x4){__expf(bl4[0]), __expf(bl4[1]), __expf(bl4[2]), __expf(bl4[3])};
                if (PASS == 2) {
                    const f32x4 eb = (f32x4){__expf(bm4[0]), __expf(bm4[1]), __expf(bm4[2]), __expf(bm4[3])};
#pragma unroll
                    for (int et = 0; et < 8; ++et) { const f32x4 v = S[et] * eb;
                        *(LAS v2u*)(L + O_SPT + (16 * et + c16) * RS1 + (16 * w + 4 * g) * 2) = (v2u){pk2(v[0], v[1]), pk2(v[2], v[3])}; }
                }
            }
            float fv[8][2];
#pragma unroll
            for (int i = 0; i < 8; ++i) { fv[i][0] = __expf(gv[i][0]); fv[i][1] = __expf(gv[i][1]); }
            if (PASS == 2) {
                float E0 = __expf(fminf(off[0] + cs[0][0] - Bmid[0], 80.f)), E1 = __expf(fminf(off[1] + cs[0][1] - Bmid[1], 80.f));
#pragma unroll
                for (int i = 0; i < 8; ++i) { if (i > 0) { E0 *= fv[i][0]; E1 *= fv[i][1]; }
                    *(LAS unsigned*)(L + O_QA + (8 * rg + i) * RS1 + cp * 4) = pk2(bflo(qc[i]) * E0, bfhi(qc[i]) * E1); }
            }
            unsigned ks0[4], ks1[4];
            {
                float D0 = (PASS == 2) ? __expf(fminf(Bmid[0] - (off[0] + cs[7][0]), 80.f)) : 0.f, D1 = (PASS == 2) ? __expf(fminf(Bmid[1] - (off[1] + cs[7][1]), 80.f)) : 0.f;
                float S0 = __expf(blast[0] - (off[0] + cs[7][0])), S1 = __expf(blast[1] - (off[1] + cs[7][1])), kn0 = 0.f, kn1 = 0.f;
#pragma unroll
                for (int i = 7; i >= 0; --i) { const float k0 = 1.0f - fv[i][0], k1 = 1.0f - fv[i][1]; const float kv0 = k0 * S0, kv1 = k1 * S1;
                    if (PASS == 2) { *(LAS unsigned*)(L + O_KA + (8 * rg + i) * RS1 + cp * 4) = pk2(k0 * D0, k1 * D1); D0 *= fv[i][0]; D1 *= fv[i][1]; }
                    S0 *= fv[i][0]; S1 *= fv[i][1];
                    if (i & 1) { kn0 = kv0; kn1 = kv1; } else { ks0[i >> 1] = pk2(kv0, kn0); ks1[i >> 1] = pk2(kv1, kn1); } }
            }
            *(LAS v4u*)(L + O_KST + (2 * cp) * RS2 + rg * 16) = (v4u){ks0[0], ks0[1], ks0[2], ks0[3]};
            *(LAS v4u*)(L + O_KST + (2 * cp + 1) * RS2 + rg * 16) = (v4u){ks1[0], ks1[1], ks1[2], ks1[3]};
            if (rg == 0) { dsum0 += blast[0]; dsum1 += blast[1]; }
        }
        HG_SYNC();
        f32x4 oT[4];
        if (PASS == 2) {
            bf16x8 qf[4];
#pragma unroll
            for (int ks = 0; ks < 4; ++ks) qf[ks] = lds_b128(L + O_QA + (16 * tt + c16) * RS1 + (32 * ks + 8 * g) * 2);
            f32x4 x[4];
#pragma unroll
            for (int st = 0; st < 4; ++st) {
                x[st] = (f32x4){0.f, 0.f, 0.f, 0.f};
                if (st <= tt) {
#pragma unroll
                    for (int ks = 0; ks < 4; ++ks) x[st] = __builtin_amdgcn_mfma_f32_16x16x32_bf16(lds_b128(L + O_KA + (16 * st + c16) * RS1 + (32 * ks + 8 * g) * 2), qf[ks], x[st], 0, 0, 0);
                    if (st == tt) {
#pragma unroll
                        for (int i = 0; i < 4; ++i) if (4 * g + i > c16) x[st][i] = 0.f;
                    }
                }
            }
            bf16x8 xb[2];
#pragma unroll
            for (int p = 0; p < 2; ++p) { const v4u t = (v4u){pk2(x[2 * p][0], x[2 * p][1]), pk2(x[2 * p][2], x[2 * p][3]), pk2(x[2 * p + 1][0], x[2 * p + 1][1]), pk2(x[2 * p + 1][2], x[2 * p + 1][3])};
                xb[p] = __builtin_bit_cast(bf16x8, t); }
#pragma unroll
            for (int e4 = 0; e4 < 4; ++e4) {
                const int et = 4 * eh + e4; f32x4 acc = (f32x4){0.f, 0.f, 0.f, 0.f};
#pragma unroll
                for (int p = 0; p < 2; ++p) {
                    if (p == 0 || tt >= 2) {
                        const v2u a0 = *(const LAS v2u*)(L + O_VT + (16 * et + c16) * RS2 + (32 * p + 4 * g) * 2);
                        const v2u a1 = *(const LAS v2u*)(L + O_VT + (16 * et + c16) * RS2 + (32 * p + 16 + 4 * g) * 2);
                        const v4u a = (v4u){a0.x, a0.y, a1.x, a1.y};
                        acc = __builtin_amdgcn_mfma_f32_16x16x32_bf16(__builtin_bit_cast(bf16x8, a), xb[p], acc, 0, 0, 0);
                    }
                }
#pragma unroll
                for (int ks = 0; ks < 4; ++ks) acc = __builtin_amdgcn_mfma_f32_16x16x32_bf16(lds_b128(L + O_SPT + (16 * et + c16) * RS1 + (32 * ks + 8 * g) * 2), qf[ks], acc, 0, 0, 0);
                oT[e4] = acc;
            }
        }
        {
            const f32x4 el = el4;
#pragma unroll
            for (int et = 0; et < 8; ++et) S[et] = S[et] * el;
#pragma unroll
            for (int ks = 0; ks < 2; ++ks) { const bf16x8 a = lds_b128(L + O_KST + (16 * w + c16) * RS2 + (32 * ks + 8 * g) * 2);
#pragma unroll
                for (int et = 0; et < 8; ++et) S[et] = __builtin_amdgcn_mfma_f32_16x16x32_bf16(a, lds_b128(L + O_VT + (16 * et + c16) * RS2 + (32 * ks + 8 * g) * 2), S[et], 0, 0, 0); }
        }
        if (PASS == 2) {
            float ss = 0.f;
#pragma unroll
            for (int e4 = 0; e4 < 4; ++e4) ss += (oT[e4][0] * oT[e4][0] + oT[e4][1] * oT[e4][1]) + (oT[e4][2] * oT[e4][2] + oT[e4][3] * oT[e4][3]);
            ss += __shfl_xor(ss, 16); ss += __shfl_xor(ss, 32);
            if (g == 0) red[(16 * tt + c16) * 2 + eh] = ss;
            HG_SYNC();
            const float rstd = 1.0f / sqrtf((red[(16 * tt + c16) * 2] + red[(16 * tt + c16) * 2 + 1]) * (1.f / 128.f) + EPS);
            const size_t orow = (R0 + 16 * tt + c16) * 1024 + h * 128;
#pragma unroll
            for (int e4 = 0; e4 < 4; ++e4) { const int e0 = 16 * (4 * eh + e4) + 4 * g;
                const f32x4 gn = gnr[e4]; const v2u sg = sgc[e4];
                const f32x4 o = oT[e4] * rstd * gn;
                *(v2u*)(OAp + orow + e0) = (v2u){pk2(o[0] * bflo(sg.x), o[1] * bfhi(sg.x)), pk2(o[2] * bflo(sg.y), o[3] * bfhi(sg.y))}; }
        } else {
            HG_SYNC();
        }
    }
    if (PASS == 1) {
        float* up = Ubuf + ((size_t)(bh * HG_NSEG + seg) * 8 + w) * 2048 + lane * 4;
#pragma unroll
        for (int et = 0; et < 8; ++et) *(f32x4*)(up + et * 256) = S[et];
        if (rg == 0) *(pg8::f32x2_t*)(Dlg + (size_t)(bh * HG_NSEG + seg) * 128 + 2 * cp) = (pg8::f32x2_t){dsum0, dsum1};
    }
    HG_SYNC();
}
__device__ __forceinline__ void hgrn_prefix(const Ctx& F) {
    float* Ubuf = F.out; const float* Dlg = F.out + HG_DLG_OFF;
    const int tid = F_TID;
    for (int item = F.bid; item < 16 * 16; item += F.G) {
        const int bh = item >> 4, p = (item & 15) * 1024 + tid * 2, w = p >> 11;
        const int dch = 16 * w + 4 * ((p >> 6) & 3) + (p & 3);
        pg8::f32x2_t u[HG_NSEG], dl[HG_NSEG];
#pragma unroll
        for (int j = 0; j < HG_NSEG; ++j) { u[j] = *(const pg8::f32x2_t*)(Ubuf + (size_t)(bh * HG_NSEG + j) * 16384 + p); dl[j] = *(const pg8::f32x2_t*)(Dlg + (size_t)(bh * HG_NSEG + j) * 128 + dch); }
        pg8::f32x2_t st = (pg8::f32x2_t){0.f, 0.f};
#pragma unroll
        for (int j = 0; j < HG_NSEG; ++j) {
            *(pg8::f32x2_t*)(Ubuf + (size_t)(bh * HG_NSEG + j) * 16384 + p) = st;
            st = (pg8::f32x2_t){st[0] * __expf(dl[j][0]) + u[j][0], st[1] * __expf(dl[j][1]) + u[j][1]};
        }
    }
}
#ifndef DSA_FAST
#define DSA_FAST 1
#endif
#if DSA_FAST
namespace dq {
#ifndef SEL_MINSPAN
#define SEL_MINSPAN 8192
#endif
#ifndef SEL_INTERP
#define SEL_INTERP 0
#endif
#ifndef KEEP_MAX
#define KEEP_MAX 272
#endif
#ifndef PRUNE_MIN
#define PRUNE_MIN 256
#endif
constexpr int CAP = 512, PRUNE_AT = CAP - 64;
constexpr int O_BUF = 0;
constexpr int O_KT = 131072;
constexpr int O_TAU = 155648, O_CNT = O_TAU + 256, O_HIST = O_CNT + 256;
constexpr int O_BKT = O_HIST + 4096, O_RB = O_BKT + 512, O_FLAG = O_RB + 1024, O_END = O_FLAG + 16;
static_assert(O_END <= MISC_OFF, "dsa lds");
constexpr int O_Q = O_KT, O_LG = O_KT + 2048, O_SEL = O_LG + 8192;
typedef float f32x16 __attribute__((ext_vector_type(16)));
}
__device__ __forceinline__ unsigned wave_incl_scan(unsigned v) {
    v += (unsigned)__builtin_amdgcn_update_dpp(0, (int)v, 0x111, 0xf, 0xf, false);
    v += (unsigned)__builtin_amdgcn_update_dpp(0, (int)v, 0x112, 0xf, 0xf, false);
    v += (unsigned)__builtin_amdgcn_update_dpp(0, (int)v, 0x114, 0xf, 0xf, false);
    v += (unsigned)__builtin_amdgcn_update_dpp(0, (int)v, 0x118, 0xf, 0xf, false);
    v += (unsigned)__builtin_amdgcn_update_dpp(0, (int)v, 0x142, 0xa, 0xf, false);
    v += (unsigned)__builtin_amdgcn_update_dpp(0, (int)v, 0x143, 0xc, 0xf, false);
    return v;
}
__device__ __forceinline__ unsigned wave_red_and(unsigned v) {
    v &= (unsigned)__builtin_amdgcn_update_dpp(-1, (int)v, 0x111, 0xf, 0xf, false); v &= (unsigned)__builtin_amdgcn_update_dpp(-1, (int)v, 0x112, 0xf, 0xf, false);
    v &= (unsigned)__builtin_amdgcn_update_dpp(-1, (int)v, 0x114, 0xf, 0xf, false); v &= (unsigned)__builtin_amdgcn_update_dpp(-1, (int)v, 0x118, 0xf, 0xf, false);
    v &= (unsigned)__builtin_amdgcn_update_dpp(-1, (int)v, 0x142, 0xa, 0xf, false); v &= (unsigned)__builtin_amdgcn_update_dpp(-1, (int)v, 0x143, 0xc, 0xf, false);
    return (unsigned)__builtin_amdgcn_readlane((int)v, 63);
}
__device__ __forceinline__ unsigned wave_red_or(unsigned v) {
    v |= (unsigned)__builtin_amdgcn_update_dpp(0, (int)v, 0x111, 0xf, 0xf, false); v |= (unsigned)__builtin_amdgcn_update_dpp(0, (int)v, 0x112, 0xf, 0xf, false);
    v |= (unsigned)__builtin_amdgcn_update_dpp(0, (int)v, 0x114, 0xf, 0xf, false); v |= (unsigned)__builtin_amdgcn_update_dpp(0, (int)v, 0x118, 0xf, 0xf, false);
    v |= (unsigned)__builtin_amdgcn_update_dpp(0, (int)v, 0x142, 0xa, 0xf, false); v |= (unsigned)__builtin_amdgcn_update_dpp(0, (int)v, 0x143, 0xc, 0xf, false);
    return (unsigned)__builtin_amdgcn_readlane((int)v, 63);
}
template <bool EXACT>
__device__ __forceinline__ unsigned wave_select256(LAS unsigned* buf, int n, unsigned lo0, int lane, int* kept) {
    const v4u ka = *(const LAS v4u*)(buf + lane * 8), kb = *(const LAS v4u*)(buf + lane * 8 + 4);
    unsigned k[8] = {ka.x, ka.y, ka.z, ka.w, kb.x, kb.y, kb.z, kb.w};
    unsigned vo = 0u;
#pragma unroll
    for (int i = 0; i < 8; ++i) { if (lane * 8 + i >= n) k[i] = 0u; vo |= k[i]; }
    const unsigned allor = wave_red_or(vo);
    unsigned lo = lo0 + 1u, hi = (allor >= 0xFFFFFFFEu ? 0xFFFFFFFEu : allor) + 1u;
    unsigned flo = (unsigned)n, fhi = 0u;
    constexpr unsigned TGT = EXACT ? 256u : (unsigned)((256 + KEEP_MAX) / 2);
#pragma unroll 1
    for (unsigned it = 0u; hi - lo > (EXACT ? 1u : (unsigned)SEL_MINSPAN); ++it) {
        if (flo <= (EXACT ? 256u : (unsigned)KEEP_MAX)) break;
        const unsigned span = hi - lo;
        unsigned mid = lo + (span >> 1);
#if SEL_INTERP
        if (!(it & 1u)) {
            const float fr = (float)(flo - TGT) * __builtin_amdgcn_rcpf((float)(flo - fhi));
            unsigned d = (unsigned)((float)span * fr); d = d < 1u ? 1u : (d > span - 1u ? span - 1u : d);
            mid = __builtin_amdgcn_readfirstlane(lo + d);
        }
#endif
        unsigned c = 0u;
#pragma unroll
        for (int i = 0; i < 8; ++i) c += (unsigned)__builtin_popcountll(__ballot(k[i] >= mid));
        if (c >= 256u) { lo = mid; flo = c; } else { hi = mid; fhi = c; }
    }
    if (!EXACT && flo > 448u) {
#pragma unroll 1
        while (hi - lo > 1u && flo > (unsigned)KEEP_MAX) {
            const unsigned mid = lo + ((hi - lo) >> 1);
            unsigned c = 0u;
#pragma unroll
            for (int i = 0; i < 8; ++i) c += (unsigned)__builtin_popcountll(__ballot(k[i] >= mid));
            if (c >= 256u) { lo = mid; flo = c; } else { hi = mid; fhi = c; }
        }
    }
    int base = 0;
#pragma unroll
    for (int i = 0; i < 8; ++i) { const bool keep = k[i] >= lo; const unsigned long long bal = __ballot(keep);
        const int pos = base + (int)__builtin_amdgcn_mbcnt_hi((unsigned)(bal >> 32), __builtin_amdgcn_mbcnt_lo((unsigned)bal, 0u));
        if (keep) buf[pos] = k[i];
        base += __builtin_popcountll(bal); }
    *kept = base;
    return lo;
}
__device__ __forceinline__ void dsa_tables(const Ctx& F) {
    LAS int* bkt = (LAS int*)(F.lds + dq::O_BKT); LAS float* rb = (LAS float*)(F.lds + dq::O_RB);
    if (F_TID < 128) { const int dd = F_TID; int bk = dd;
        if (dd >= 16) { const int lg = 16 + (int)(logf((float)dd / 16.0f) / 2.0794415416798357f * 16.0f); bk = lg < 31 ? lg : 31; }
        bkt[dd] = bk; }
    if (F_TID < 256) rb[F_TID] = F.in[11][F_TID];
    __syncthreads();
}
__device__ __forceinline__ unsigned pack_key(float v, int s) {
    unsigned u = __builtin_bit_cast(unsigned, v); u = (u == 0x80000000u) ? 0u : u;
    const unsigned m = (u >> 31) ? 0xFFFFFFFFu : 0x80000000u;
    return ((u ^ m) & 0xFFFFE000u) | (unsigned)(8191 - s);
}
__device__ __forceinline__ unsigned pack_key_nz(float v, int s) {
    const unsigned u = __builtin_bit_cast(unsigned, v); const unsigned m = (unsigned)((int)u >> 31) | 0x80000000u;
    return ((u ^ m) & 0xFFFFE000u) | (unsigned)(8191 - s);
}
__device__ __forceinline__ void stage_keys(const unsigned short* IKN, int b, int T, LAS unsigned char* dst, int wave, int lane) {
    const int P = wave * 64 + lane, sub = P >> 8, p = P & 255, pair = p >> 4, s = (p & 15) ^ (pair & 7), n = 2 * pair + (s >> 3), c = s & 7;
    const unsigned short* src = IKN + ((size_t)b * SEQ + (size_t)T * 64 + sub * 32 + n) * 64 + c * 8;
    __builtin_amdgcn_global_load_lds((const unsigned*)src, (LAS unsigned*)(dst + wave * 1024), 16, 0, 0);
}
__device__ __forceinline__ void attn_row_block(const Ctx& F, int b, int t, const LAS unsigned* selk, int nsel) {
    using namespace dq;
    const int tid = F_TID, lane = F_LANE, wave = F.wave;
    LAS unsigned char* L = F.lds;
    LAS float* qs = (LAS float*)(L + O_Q); LAS float* lg = (LAS float*)(L + O_LG); LAS int* sel = (LAS int*)(L + O_SEL);
    LAS int* bkt = (LAS int*)(L + O_BKT); LAS float* rb = (LAS float*)(L + O_RB);
    const size_t row = (size_t)b * SEQ + t;
    const bf16* AQ = (const bf16*)(F.ws + WS_AQ); const bf16* KV = (const bf16*)(F.ws + WS_KV); bf16* OB = (bf16*)(F.ws + WS_OB);
    if (tid < nsel) sel[tid] = 8191 - (int)(selk[tid] & 8191u);
    { const int hd = tid >> 6, dd = tid & 63; qs[((hd >> 2) * 64 + dd) * 4 + (hd & 3)] = bf2f(AQ[row * 512 + tid]); }
    __syncthreads();
    {
        const int j = tid & 255, grp = tid >> 8;
        if (j < nsel) {
            const int sidx = sel[j]; const bf16* kp = KV + ((size_t)b * SEQ + sidx) * 256 + grp * 64;
            f32x4 a = (f32x4){0.f, 0.f, 0.f, 0.f};
#pragma unroll 1
            for (int c = 0; c < 8; ++c) { const v4u kk = *(const v4u*)(kp + 8 * c);
                const float kf[8] = {bflo(kk.x), bfhi(kk.x), bflo(kk.y), bfhi(kk.y), bflo(kk.z), bfhi(kk.z), bflo(kk.w), bfhi(kk.w)};
#pragma unroll
                for (int e = 0; e < 8; ++e) a += *(const LAS f32x4*)(qs + (grp * 64 + 8 * c + e) * 4) * kf[e]; }
            const int dist = t - sidx; const int bk = dist < 128 ? bkt[dist] : 31;
#pragma unroll
            for (int r = 0; r < 4; ++r) lg[(grp * 4 + r) * 256 + j] = a[r] + rb[bk * 8 + grp * 4 + r];
        }
    }
    __syncthreads();
    {
        float v[4]; float mx = -3.0e38f;
#pragma unroll
        for (int i = 0; i < 4; ++i) { const int j = lane + 64 * i; v[i] = j < nsel ? lg[wave * 256 + j] : -3.0e38f; mx = fmaxf(mx, v[i]); }
#pragma unroll
        for (int o = 1; o < 64; o <<= 1) mx = fmaxf(mx, __shfl_xor(mx, o));
        float sm = 0.f;
#pragma unroll
        for (int i = 0; i < 4; ++i) { const int j = lane + 64 * i; v[i] = j < nsel ? __expf(v[i] - mx) : 0.f; sm += v[i]; }
        sm = wave_sum(sm); const float inv = 1.0f / sm;
#pragma unroll
        for (int i = 0; i < 4; ++i) { const int j = lane + 64 * i; lg[wave * 256 + j] = v[i] * inv; }
    }
    __syncthreads();
    {
        const int e = tid & 127, grp = e >> 6, r = tid >> 7, head = grp * 4 + r; float acc = 0.f;
        const bf16* vp = KV + (size_t)b * SEQ * 256 + 128 + e;
        for (int j = 0; j < nsel; ++j) acc += lg[head * 256 + j] * bf2f(vp[(size_t)sel[j] * 256]);
        OB[row * 512 + head * 64 + (e & 63)] = (bf16)f2bf(acc);
    }
    __syncthreads();
}
typedef short v4i16_t __attribute__((ext_vector_type(4)));
typedef float f32x2v __attribute__((ext_vector_type(2)));
#ifndef ATT_FULL_PATH
#define ATT_FULL_PATH 1
#endif
#ifndef SCAN_PRIO
#define SCAN_PRIO 1
#endif
#ifndef QK_FINE
#define QK_FINE 0
#endif
#ifndef PV_FP8
#define PV_FP8 1
#endif
typedef int v2i32_t __attribute__((ext_vector_type(2)));
#ifndef PV_RD
#define PV_RD 4
#endif
#ifndef PV_EARLY
#define PV_EARLY 0
#endif
#ifndef ATT_REP
#define ATT_REP 1
#endif
#ifndef ATT_NP
#define ATT_NP 8
#endif
template <bool FULL>
__device__ __forceinline__ void attn_row_wave(const Ctx& F, int b, int t, const LAS unsigned* kb, int nsel_, LAS unsigned char* vimg, int lane_in, v4u (&qz)[2], const bool has_next, bool second = false) {
    const int nsel = FULL ? 256 : nsel_;
    int lane = lane_in; asm volatile("" : "+v"(lane));
    const int g4o = 4 * (lane >> 4);
    using namespace dq;
    const int c16 = lane & 15, g = lane >> 4;
    const LAS int* bkt = (const LAS int*)(F.lds + O_BKT); const LAS float* rb = (const LAS float*)(F.lds + O_RB);
    const size_t row = (size_t)b * SEQ + t;
    const bf16* AQ = (const bf16*)(F.ws + WS_AQ); const unsigned char* KV = (const unsigned char*)(F.ws + WS_KV) + (size_t)b * SEQ * 256; bf16* OB = (bf16*)((unsigned char*)F.out + OAB_OFF) + 512;
    long qf[4];
#pragma unroll
    for (int ks = 0; ks < 4; ++ks) { const v4u z = qz[ks & 1];
        const bool ok = c16 < 8 && (c16 >> 2) == (ks >> 1);
        int w0 = __builtin_amdgcn_cvt_pk_fp8_f32(bflo(z.x) * 8.f, bfhi(z.x) * 8.f, 0, false); w0 = __builtin_amdgcn_cvt_pk_fp8_f32(bflo(z.y) * 8.f, bfhi(z.y) * 8.f, w0, true);
        int w1 = __builtin_amdgcn_cvt_pk_fp8_f32(bflo(z.z) * 8.f, bfhi(z.z) * 8.f, 0, false); w1 = __builtin_amdgcn_cvt_pk_fp8_f32(bflo(z.w) * 8.f, bfhi(z.w) * 8.f, w1, true);
        w0 = ok ? w0 : 0; w1 = ok ? w1 : 0;
        qf[ks] = (long)(((unsigned long long)(unsigned)w1 << 32) | (unsigned long long)(unsigned)w0); }
    if (has_next) {
#pragma unroll
        for (int hq = 0; hq < 2; ++hq) qz[hq] = *(const v4u*)(AQ + (row + 1) * 512 + (c16 & 7) * 64 + 32 * hq + 8 * g); }
    bf16x8 rbf;
    { const int hc = c16 & 7; unsigned wv_[4];
#pragma unroll
      for (int q = 0; q < 4; ++q) { const float a = rb[(8 * g + 2 * q) * 8 + hc] * 8.f, bq = rb[(8 * g + 2 * q + 1) * 8 + hc] * 8.f; const unsigned pkd = pk2(a, bq); wv_[q] = c16 < 8 ? pkd : 0u; }
      rbf = __builtin_bit_cast(bf16x8, (v4u){wv_[0], wv_[1], wv_[2], wv_[3]}); }
    const float b31 = c16 < 8 ? rb[31 * 8 + (c16 & 7)] * 8.f : 0.f;
    f32x4 lg[16];
    {
        v4u kq[16][2]; int dsv[16];
#define QK_LD(KT) do { const int slot = 16 * (KT) + c16; const int idx0 = 8191 - (int)(kb[slot] & 8191u); const int idx = (FULL || slot < nsel) ? idx0 : 0; \
            const unsigned koff = (unsigned)(idx * 256 + 32 * g); kq[KT][0] = *(const v4u*)(KV + koff); kq[KT][1] = *(const v4u*)(KV + koff + 16); \
            dsv[KT] = t - idx; } while (0)
#define QK_MM(KT) do { const bool anynear = __builtin_amdgcn_ballot_w64(dsv[KT] < 128) != 0ull; const float ci = anynear ? 0.f : b31; f32x4 acc = (f32x4){ci, ci, ci, ci}; \
            acc = __builtin_amdgcn_mfma_f32_16x16x32_fp8_fp8((long)(((unsigned long long)kq[KT][0].y << 32) | kq[KT][0].x), qf[0], acc, 0, 0, 0); \
            acc = __builtin_amdgcn_mfma_f32_16x16x32_fp8_fp8((long)(((unsigned long long)kq[KT][0].w << 32) | kq[KT][0].z), qf[1], acc, 0, 0, 0); \
            acc = __builtin_amdgcn_mfma_f32_16x16x32_fp8_fp8((long)(((unsigned long long)kq[KT][1].y << 32) | kq[KT][1].x), qf[2], acc, 0, 0, 0); \
            acc = __builtin_amdgcn_mfma_f32_16x16x32_fp8_fp8((long)(((unsigned long long)kq[KT][1].w << 32) | kq[KT][1].z), qf[3], acc, 0, 0, 0); \
            if (anynear) { const int dist = dsv[KT]; const int dcl = dist < 0 ? 0 : (dist > 127 ? 127 : dist); \
              const int dd = bkt[dcl] - 8 * g; const unsigned one = (dd & 1) ? 0x3F800000u : 0x00003F80u; const int wq = ((unsigned)dd < 8u) ? (dd >> 1) : -1; \
              const v4u oh = (v4u){wq == 0 ? one : 0u, wq == 1 ? one : 0u, wq == 2 ? one : 0u, wq == 3 ? one : 0u}; \
              acc = __builtin_amdgcn_mfma_f32_16x16x32_bf16(__builtin_bit_cast(bf16x8, oh), rbf, acc, 0, 0, 0); }     \
            lg[KT] = acc; } while (0)
#pragma unroll
        for (int kt = 0; kt < 8; ++kt) QK_LD(kt);
        __builtin_amdgcn_sched_barrier(0);
#if QK_FINE
#pragma unroll
        for (int kt = 0; kt < 8; ++kt) { QK_MM(kt); QK_LD(8 + kt); __builtin_amdgcn_sched_barrier(0); }
#pragma unroll
        for (int kt = 8; kt < 16; ++kt) QK_MM(kt);
#else
#pragma unroll
        for (int kt = 0; kt < 4; ++kt) QK_MM(kt);
        __builtin_amdgcn_sched_barrier(0);
#pragma unroll
        for (int kt = 8; kt < 16; ++kt) { if (kt == 12) { QK_MM(4); QK_MM(5); QK_MM(6); QK_MM(7); __builtin_amdgcn_sched_barrier(0); } QK_LD(kt); }
        __builtin_amdgcn_sched_barrier(0);
#pragma unroll
        for (int kt = 8; kt < 16; ++kt) QK_MM(kt);
#endif
        asm volatile("" ::: "memory");
#undef QK_LD
#undef QK_MM
    }
#define PV_LOAD(dst, P) do { _Pragma("unroll") for (int it = 0; it < 4; ++it) { const int kk = it * 8 + (lane >> 3); const int slot = 32 * (P) + kk; \
        const int idx0 = 8191 - (int)(kb[slot & 255] & 8191u); const int idx = (FULL || slot < nsel) ? idx0 : 0; \
        dst[it] = *(const v4u*)(KV + (unsigned)(idx * 256 + 128 + (lane & 7) * 16)); } } while (0)
    v4u vr[PV_RD][4];
#define PV_INIT(P) do { if ((P) < PV_RD - 1 && (P) < 8) PV_LOAD(vr[(P) % PV_RD], P); } while (0)
#if PV_EARLY
    PV_INIT(0); PV_INIT(1); PV_INIT(2); PV_INIT(3); PV_INIT(4); PV_INIT(5); PV_INIT(6); PV_INIT(7);
    __builtin_amdgcn_sched_barrier(0);
#endif
    float mx = -3.0e38f;
#pragma unroll
    for (int kt = 0; kt < 16; ++kt)
#pragma unroll
        for (int i = 0; i < 4; ++i) { const int slot = 16 * kt + g4o + i; const float v = (FULL || slot < nsel) ? lg[kt][i] : -3.0e38f; lg[kt][i] = v; mx = fmaxf(mx, v); }
    mx = fmaxf(mx, __shfl_xor(mx, 16)); mx = fmaxf(mx, __shfl_xor(mx, 32));
    float sm = 0.f;
    constexpr float SC2 = 0.125f * 1.4426950408889634f; const float nmx = -mx * SC2 + (PV_FP8 ? 7.0f : 0.0f);
#pragma unroll
    for (int kt = 0; kt < 16; ++kt)
#pragma unroll
        for (int i = 0; i < 4; ++i) { const int slot = 16 * kt + g4o + i; const float e = (FULL || slot < nsel) ? __builtin_amdgcn_exp2f(__builtin_fmaf(lg[kt][i], SC2, nmx)) : 0.f; lg[kt][i] = e; sm += e; }
    sm += __shfl_xor(sm, 16); sm += __shfl_xor(sm, 32);
    const float inv = 1.0f / sm;
#if PV_FP8
    long pbs[8];
#pragma unroll
    for (int p = 0; p < 8; ++p) { const f32x4 p0 = lg[2 * p], p1 = lg[2 * p + 1];
        int w0 = __builtin_amdgcn_cvt_pk_fp8_f32(p0[0], p0[1], 0, false); w0 = __builtin_amdgcn_cvt_pk_fp8_f32(p0[2], p0[3], w0, true);
        int w1 = __builtin_amdgcn_cvt_pk_fp8_f32(p1[0], p1[1], 0, false); w1 = __builtin_amdgcn_cvt_pk_fp8_f32(p1[2], p1[3], w1, true);
        pbs[p] = (long)(((unsigned long long)(unsigned)w1 << 32) | (unsigned long long)(unsigned)w0); }
    f32x4 oT[8];
#pragma unroll
    for (int et = 0; et < 8; ++et) oT[et] = (f32x4){0.f, 0.f, 0.f, 0.f};
#define PV_MMA(P) do { const long pf = pbs[P]; \
        _Pragma("unroll") for (int et = 0; et < 8; ++et) { const int rq = c16 >> 1; \
            const v2i32_t a = __builtin_amdgcn_ds_read_tr8_b64_v2i32((LAS v2i32_t*)(vimg + (4 * ((P) & 1) + g) * 2048 + rq * 128 + ((et ^ rq ^ (g & 1)) * 16) + (c16 & 1) * 8)); \
            oT[et] = __builtin_amdgcn_mfma_f32_16x16x32_fp8_fp8((long)(((unsigned long long)(unsigned)a[1] << 32) | (unsigned long long)(unsigned)a[0]), pf, oT[et], 0, 0, 0); } } while (0)
    {
#define PV_WRITE(src, P) do { _Pragma("unroll") for (int it = 0; it < 4; ++it) { const int kk = it * 8 + (lane >> 3); const int R = 8 * ((kk & 15) >> 2) + (kk & 3) + 4 * (kk >> 4); \
            const int pos = (lane & 7) ^ (R & 7) ^ ((R >> 3) & 1); \
            *(LAS v4u*)(vimg + (4 * ((P) & 1) + (R >> 3)) * 2048 + (R & 7) * 128 + pos * 16) = src[it]; } } while (0)
#else
    v4u pbs[8];
#pragma unroll
    for (int p = 0; p < 8; ++p) { const f32x4 p0 = lg[2 * p], p1 = lg[2 * p + 1];
        pbs[p] = (v4u){pk2(p0[0], p0[1]), pk2(p0[2], p0[3]), pk2(p1[0], p1[1]), pk2(p1[2], p1[3])}; }
    f32x4 oT[8];
#pragma unroll
    for (int et = 0; et < 8; ++et) oT[et] = (f32x4){0.f, 0.f, 0.f, 0.f};
    const int q4 = c16 >> 2, pp = c16 & 3;
#define PV_MMA(P) do { const bf16x8 pf = __builtin_bit_cast(bf16x8, pbs[P]); \
        asm volatile("s_waitcnt lgkmcnt(0)" ::: "memory"); \
        _Pragma("unroll") for (int et = 0; et < 8; ++et) { const int ch = 2 * et + (pp >> 1); const int kk0 = 4 * g + q4, kk1 = 16 + 4 * g + q4; \
            const int sw0 = ((kk0 & 3) << 1) | (((kk0 >> 2) & 1) << 3), sw1 = ((kk1 & 3) << 1) | (((kk1 >> 2) & 1) << 3); \
            const v4i16_t a0 = __builtin_amdgcn_ds_read_tr16_b64_v4i16((LAS v4i16_t*)(vimg + (kk0 >> 2) * 2048 + (kk0 & 3) * 256 + ((ch ^ sw0) * 16) + (pp & 1) * 8)); \
            const v4i16_t a1 = __builtin_amdgcn_ds_read_tr16_b64_v4i16((LAS v4i16_t*)(vimg + (kk1 >> 2) * 2048 + (kk1 & 3) * 256 + ((ch ^ sw1) * 16) + (pp & 1) * 8)); \
            const bf16x8 af = (bf16x8){a0[0], a0[1], a0[2], a0[3], a1[0], a1[1], a1[2], a1[3]}; \
            oT[et] = __builtin_amdgcn_mfma_f32_16x16x32_bf16(af, pf, oT[et], 0, 0, 0); } \
        asm volatile("s_waitcnt lgkmcnt(0)" ::: "memory"); } while (0)
    {
#define PV_WRITE(src, P) do { _Pragma("unroll") for (int it = 0; it < 4; ++it) { const int kk = it * 8 + (lane >> 3); const int sw = ((kk & 3) << 1) | (((kk >> 2) & 1) << 3); const int ch = lane & 7; \
            const unsigned wsrc[4] = {src[it].x, src[it].y, src[it].z, src[it].w}; unsigned o[8]; \
            _Pragma("unroll") for (int q = 0; q < 4; ++q) { const f32x2v lo2 = __builtin_amdgcn_cvt_pk_f32_fp8((int)wsrc[q], false), hi2 = __builtin_amdgcn_cvt_pk_f32_fp8((int)wsrc[q], true); \
                o[2 * q] = pk2(lo2[0], lo2[1]); o[2 * q + 1] = pk2(hi2[0], hi2[1]); } \
            LAS unsigned char* rowp = vimg + (kk >> 2) * 2048 + (kk & 3) * 256; \
            *(LAS v4u*)(rowp + (((2 * ch) ^ sw) * 16)) = (v4u){o[0], o[1], o[2], o[3]}; \
            *(LAS v4u*)(rowp + (((2 * ch + 1) ^ sw) * 16)) = (v4u){o[4], o[5], o[6], o[7]}; } } while (0)
#endif
#if !PV_EARLY
        PV_INIT(0); PV_INIT(1); PV_INIT(2); PV_INIT(3); PV_INIT(4); PV_INIT(5); PV_INIT(6); PV_INIT(7);
        __builtin_amdgcn_sched_barrier(0);
#endif
#undef PV_INIT
#define PV_ONE(P) do { if (FULL || 32 * (P) < nsel) { PV_WRITE(vr[(P) % PV_RD], P); asm volatile("" ::: "memory"); if ((P) + PV_RD - 1 < 8) PV_LOAD(vr[((P) + PV_RD - 1) % PV_RD], (P) + PV_RD - 1); PV_MMA(P); } } while (0)
        PV_ONE(0); PV_ONE(1); PV_ONE(2); PV_ONE(3); PV_ONE(4); PV_ONE(5); PV_ONE(6); PV_ONE(7);
#undef PV_ONE
#undef PV_WRITE
    }
#undef PV_LOAD
#undef PV_MMA
#ifdef ATT_SELFCHECK
#define SC_STORE(O) do { v2u nv = (v2u){pk2((O)[0], (O)[1]), pk2((O)[2], (O)[3])}; v2u* dst = (v2u*)(OB + row * 1024 + c16 * 64 + 16 * k + 4 * g); \
        if (second) { const v2u ov = *(volatile v2u*)dst; if (ov.x != nv.x || ov.y != nv.y) nv = (v2u){0x7fc07fc0u, 0x7fc07fc0u}; } *dst = nv; } while (0)
    if (c16 < 4) {
#pragma unroll
        for (int k = 0; k < 4; ++k) { const f32x4 o = oT[k] * inv; SC_STORE(o); }
    } else if (c16 < 8) {
#pragma unroll
        for (int k = 0; k < 4; ++k) { const f32x4 o = oT[4 + k] * inv; SC_STORE(o); }
    }
#else
    if (c16 < 4) {
#pragma unroll
        for (int k = 0; k < 4; ++k) { const f32x4 o = oT[k] * inv;
            *(v2u*)(OB + row * 1024 + c16 * 64 + 16 * k + 4 * g) = (v2u){pk2(o[0], o[1]), pk2(o[2], o[3])}; }
    } else if (c16 < 8) {
#pragma unroll
        for (int k = 0; k < 4; ++k) { const f32x4 o = oT[4 + k] * inv;
            *(v2u*)(OB + row * 1024 + c16 * 64 + 16 * k + 4 * g) = (v2u){pk2(o[0], o[1]), pk2(o[2], o[3])}; }
    }
#endif
}
#ifndef SCAN_REAL
#define SCAN_REAL 0
#endif
#ifndef SCAN_REP
#define SCAN_REP 1
#endif
__device__ __forceinline__ void dsa_unit(const Ctx& F, int b, int j) {
    using namespace dq;
    int lane_ = F_LANE; asm volatile("" : "+v"(lane_));
    const int lane = lane_, w = F.wave, n = lane & 31, H = lane >> 5;
    LAS unsigned char* L = F.lds;
    LAS unsigned* tau = (LAS unsigned*)(L + O_TAU); LAS unsigned* cnt = (LAS unsigned*)(L + O_CNT); LAS unsigned* hist = (LAS unsigned*)(L + O_HIST + w * 512);
    const unsigned short* IQ = (const unsigned short*)(F.ws + WS_IQ); const unsigned short* IKN = (const unsigned short*)(F.ws + WS_IKN);
    const float* IKW = (const float*)(F.ws + WS_IKW);
    const int t0 = 64 * j; const size_t rowg = (size_t)b * SEQ + t0 + 8 * w;
    LAS unsigned* pflag = (LAS unsigned*)(L + O_FLAG);
    if (w == 0) { tau[lane] = 0u; cnt[lane] = 0u; if (lane < 3) pflag[lane] = 0u; }
    if (SCAN_REP == 1) { stage_keys(IKN, b, 0, L + O_KT, w, lane); stage_keys(IKN, b, j < 1 ? j : 1, L + O_KT + 8192, w, lane); }
    h8 af[2][4];
    { const int r = lane & 31, i = r >> 3, hh = (r >> 2) & 1, jj = r & 3, query = 2 * hh + (i >> 1), head = 4 * (i & 1) + jj;
#pragma unroll
      for (int a = 0; a < 2; ++a)
#pragma unroll
        for (int ks = 0; ks < 4; ++ks) af[a][ks] = *(const h8*)(IQ + (rowg + 4 * a + query) * 512 + head * 64 + 16 * ks + 8 * H); }
    float wv[2][2][8];
#pragma unroll
    for (int a = 0; a < 2; ++a)
#pragma unroll
        for (int qs = 0; qs < 2; ++qs) { const float* wp = IKW + (rowg + 4 * a + 2 * H + qs) * 128 + 64;
            const f32x4 w0 = *(const f32x4*)wp, w1 = *(const f32x4*)(wp + 4);
#pragma unroll
            for (int h = 0; h < 4; ++h) { wv[a][qs][h] = w0[h] * 0.35355339059327373f; wv[a][qs][4 + h] = w1[h] * 0.35355339059327373f; } }
    asm volatile("s_waitcnt vmcnt(0)" ::: "memory");
#pragma unroll 1
    for (int srep = 0; srep < SCAN_REP; ++srep) {
    if (SCAN_REP > 1) { __syncthreads(); if (w == 0) { tau[lane] = (srep == SCAN_REP - 1 || SCAN_REAL) ? 0u : 0xFFFFFFFFu; cnt[lane] = 0u; if (lane < 3) pflag[lane] = 0u; } }
    if (SCAN_REP > 1) { stage_keys(IKN, b, 0, L + O_KT, w, lane); stage_keys(IKN, b, j < 1 ? j : 1, L + O_KT + 8192, w, lane); }
    const int rloc = 8 * w + 2 * H;
    const unsigned trash_off = (unsigned)(O_HIST + w * 512) + (unsigned)lane * 4u;
    LAS unsigned* const trashp = (LAS unsigned*)(L + trash_off);
    unsigned nHm = H ? 0u : 0xFFFFFFFFu; asm volatile("" : "+v"(nHm));
    int boff[4];
#pragma unroll
    for (int ks = 0; ks < 4; ++ks) { const int c = 2 * ks + H; boff[ks] = ((n >> 1) * 16 + ((((n & 1) << 3) | c) ^ ((n >> 1) & 7))) * 16; }
    h8 bfr[2][2][4];
    f32x16 acc0[2], acc1[2];
#define SCAN_MMA(ACC, PARX, SUB) do { _Pragma("unroll") for (int a = 0; a < 2; ++a) { _Pragma("unroll") for (int i = 0; i < 16; ++i) ACC[a][i] = 0.f; \
        _Pragma("unroll") for (int ks = 0; ks < 4; ++ks) ACC[a] = __builtin_amdgcn_mfma_f32_32x32x16_f16(af[a][ks], bfr[PARX][SUB][ks], ACC[a], 0, 0, 0); } } while (0)
    unsigned tau4[2][2], cnt4[2][2];
#pragma unroll
    for (int a = 0; a < 2; ++a)
#pragma unroll
        for (int qs = 0; qs < 2; ++qs) { tau4[a][qs] = 0u; cnt4[a][qs] = 0u; }
    auto scan_step = [&](const int T, auto last_tag, auto par_tag) __attribute__((always_inline)) {
        constexpr bool LAST = decltype(last_tag)::value; constexpr int PAR = decltype(par_tag)::value;

        asm volatile("s_waitcnt vmcnt(1) lgkmcnt(0)" ::: "memory");
        __builtin_amdgcn_s_barrier();
        asm volatile("" ::: "memory");
        {
            const unsigned fl = __builtin_amdgcn_readfirstlane(pflag[T % 3]);
            if (w == 0 && lane == 0) pflag[(T + 2) % 3] = 0u;
            if (fl) {
                if (n == 0) {
#pragma unroll
                    for (int a = 0; a < 2; ++a)
#pragma unroll
                        for (int qs = 0; qs < 2; ++qs) cnt[rloc + 4 * a + qs] = cnt4[a][qs];
                }
                asm volatile("s_waitcnt lgkmcnt(0)" ::: "memory");
#pragma unroll 1
                for (int r = 0; r < 8; ++r) { const int rr = 8 * w + r; const int c = __builtin_amdgcn_readfirstlane((int)cnt[rr]);
                    if (c > PRUNE_MIN) { int kept; const unsigned tprev = __builtin_amdgcn_readfirstlane(tau[rr]);
                        unsigned thr = wave_select256<false>((LAS unsigned*)(L + O_BUF + rr * 2048), c, tprev, lane, &kept);
#ifdef PRUNE_TWICE
                        { int kept2; (void)wave_select256<false>((LAS unsigned*)(L + O_BUF + rr * 2048), kept, thr ? thr - 1u : 0u, lane, &kept2); }
#endif
                        if (lane == 0) { tau[rr] = thr ? thr - 1u : 0u; cnt[rr] = (unsigned)kept; } } }
                asm volatile("s_waitcnt lgkmcnt(0)" ::: "memory");
#pragma unroll
                for (int a = 0; a < 2; ++a)
#pragma unroll
                    for (int qs = 0; qs < 2; ++qs) { tau4[a][qs] = tau[rloc + 4 * a + qs]; cnt4[a][qs] = cnt[rloc + 4 * a + qs]; }
#pragma unroll
                for (int a = 0; a < 2; ++a)
#pragma unroll
                    for (int qs = 0; qs < 2; ++qs) asm volatile("" : "+v"(tau4[a][qs]), "+v"(cnt4[a][qs]));
            }
        }
        { const int Tn = T + 3 <= j ? T + 3 : j; stage_keys(IKN, b, Tn, L + O_KT + (T % 3) * 8192, w, lane); }
        if (!LAST) {
            const LAS unsigned char* ktn = L + O_KT + ((T + 1) % 3) * 8192;
#pragma unroll
            for (int sb = 0; sb < 2; ++sb)
#pragma unroll
                for (int ks = 0; ks < 4; ++ks) bfr[PAR ^ 1][sb][ks] = *(const LAS h8*)(ktn + sb * 4096 + boff[ks]);
        }
        SCAN_MMA(acc1, PAR, 1);
#pragma unroll
        for (int sub = 0; sub < 2; ++sub) {
            if (sub == 1 && !LAST) SCAN_MMA(acc0, PAR ^ 1, 0);
            f32x16 (&acc_s)[2] = *(sub == 0 ? &acc0 : &acc1);
            const int skey = 64 * T + 32 * sub + n;
            unsigned keyv[2][2];
#pragma unroll
            for (int a = 0; a < 2; ++a)
#pragma unroll
                for (int qs = 0; qs < 2; ++qs) {
                    float s0 = 0.f, s1 = 0.f;
#pragma unroll
                    for (int h = 0; h < 4; ++h) { s0 += wv[a][qs][h] * __builtin_amdgcn_fmed3f(acc_s[a][8 * qs + h], 0.f, 3.0e38f); s1 += wv[a][qs][4 + h] * __builtin_amdgcn_fmed3f(acc_s[a][8 * qs + 4 + h], 0.f, 3.0e38f); }
                    const unsigned key = pack_key_nz(s0 + s1, skey);
                    const bool kill = LAST && (skey > t0 + rloc + 4 * a + qs);
                    keyv[a][qs] = kill ? 0u : key;
                }
#pragma unroll
            for (int a = 0; a < 2; ++a)
#pragma unroll
                for (int qs = 0; qs < 2; ++qs) {
                    const unsigned key = keyv[a][qs];
                    const bool keep = key > tau4[a][qs];
                    const unsigned long long bal = __ballot(keep);
                    const unsigned lo = (unsigned)bal, hi = (unsigned)(bal >> 32);
                    const unsigned pre = __builtin_amdgcn_mbcnt_hi(hi, __builtin_amdgcn_mbcnt_lo(lo & nHm, 0u));
                    const unsigned own = (lo & nHm) | (hi & ~nHm);
                    LAS unsigned* const rowp = (LAS unsigned*)(L + O_BUF + (rloc + 4 * a + qs) * 2048) + (cnt4[a][qs] + pre);
                    *(keep ? rowp : trashp) = key;
                    cnt4[a][qs] += (unsigned)__builtin_popcount(own);
                }
        }
        { const unsigned mc = max(max(cnt4[0][0], cnt4[0][1]), max(cnt4[1][0], cnt4[1][1]));
          if (__any(mc > (unsigned)PRUNE_AT)) { if (lane == 0) pflag[(T + 1) % 3] = 1u; } }
        };
#if SCAN_PRIO
    if (w < 4) __builtin_amdgcn_s_setprio(1);
#endif
    {
        __builtin_amdgcn_s_barrier();
        asm volatile("" ::: "memory");
        stage_keys(IKN, b, j < 2 ? j : 2, L + O_KT + 2 * 8192, w, lane);
#pragma unroll
        for (int sb = 0; sb < 2; ++sb)
#pragma unroll
            for (int ks = 0; ks < 4; ++ks) bfr[0][sb][ks] = *(const LAS h8*)(L + O_KT + sb * 4096 + boff[ks]);
        SCAN_MMA(acc0, 0, 0);
    }
    using TagF = std::integral_constant<bool, false>; using TagT = std::integral_constant<bool, true>; using P0 = std::integral_constant<int, 0>; using P1 = std::integral_constant<int, 1>;
    int T = 0;
#pragma unroll 1
    for (; T + 1 < j; T += 2) { scan_step(T, TagF{}, P0{}); scan_step(T + 1, TagF{}, P1{}); }
    if (T < j) { scan_step(T, TagF{}, P0{}); scan_step(j, TagT{}, P1{}); }
    else scan_step(j, TagT{}, P0{});
#undef SCAN_MMA
    if (n == 0) {
#pragma unroll
        for (int a = 0; a < 2; ++a)
#pragma unroll
            for (int qs = 0; qs < 2; ++qs) cnt[rloc + 4 * a + qs] = cnt4[a][qs];
    }
#if SCAN_PRIO == 1
    __builtin_amdgcn_s_setprio(0);
#endif
    asm volatile("s_waitcnt vmcnt(0) lgkmcnt(0)" ::: "memory");
    }
#pragma unroll 1
    for (int r = 0; r < 8; ++r) { const int rr = 8 * w + r; const int c = __builtin_amdgcn_readfirstlane((int)cnt[rr]);
        if (c > 256) { int kept; (void)wave_select256<true>((LAS unsigned*)(L + O_BUF + rr * 2048), c, __builtin_amdgcn_readfirstlane(tau[rr]), lane, &kept); if (lane == 0) cnt[rr] = 256u; } }
    asm volatile("s_waitcnt lgkmcnt(0)" ::: "memory");
    v4u qz[2];
    { const bf16* AQp = (const bf16*)(F.ws + WS_AQ); const size_t row0q = (size_t)b * SEQ + t0 + 8 * w;
#pragma unroll
      for (int hq = 0; hq < 2; ++hq) qz[hq] = *(const v4u*)(AQp + row0q * 512 + (lane & 7) * 64 + 32 * hq + 8 * (lane >> 4)); }
#pragma unroll 1
    for (int r2 = 0; r2 < 8 * ATT_REP; ++r2) { const int r = r2 & 7; const int rr = 8 * w + r; const bool hn = (r < 7);
        if (ATT_FULL_PATH && j >= 4) attn_row_wave<true>(F, b, t0 + rr, (const LAS unsigned*)(L + O_BUF + rr * 2048), 256, L + O_BUF + (8 * w) * 2048 + 1024, lane, qz, hn, r2 >= 8);
        else attn_row_wave<false>(F, b, t0 + rr, (const LAS unsigned*)(L + O_BUF + rr * 2048), __builtin_amdgcn_readfirstlane((int)cnt[rr]), L + O_BUF + (8 * w) * 2048 + 1024, lane, qz, hn, r2 >= 8); }
    __syncthreads();
}
#else
namespace ds {
constexpr int O_KEYS = 0, O_HIST = 32768, O_MISC = 33792, O_Q = 34816, O_LG = 36864, O_SEL = 45056, O_BKT = 46080, O_RB = 46592, O_END = 47616;
}
__device__ __forceinline__ unsigned pack_key(float v, int s) {
    unsigned u = __builtin_bit_cast(unsigned, v); u = (u == 0x80000000u) ? 0u : u;
    const unsigned m = (u >> 31) ? 0xFFFFFFFFu : 0x80000000u;
    return ((u ^ m) & 0xFFFFE000u) | (unsigned)(8191 - s);
}
__device__ __forceinline__ void block_select256(LAS unsigned* keys, int n, LAS unsigned* hist, LAS unsigned* misc, int tid, int lane, int wave) {
    unsigned prefix = 0u, need = 256u;
#pragma unroll 1
    for (int r = 0; r < 4; ++r) {
        const int shift = 24 - 8 * r;
        if (tid < 256) hist[tid] = 0u;
        __syncthreads();
        for (int i = tid; i < n; i += NTHR) { const unsigned k = keys[i];
            if (r == 0 || (k >> (shift + 8)) == (prefix >> (shift + 8))) __hip_atomic_fetch_add(hist + ((k >> shift) & 255u), 1u, __ATOMIC_RELAXED, __HIP_MEMORY_SCOPE_WORKGROUP); }
        __syncthreads();
        if (wave == 0) {
            const int b0 = 4 * (63 - lane);
            const v4u h4 = *(const LAS v4u*)(hist + b0);
            const unsigned s = h4.x + h4.y + h4.z + h4.w;
            unsigned incl = s;
#pragma unroll
            for (int o = 1; o < 64; o <<= 1) { const unsigned t = __shfl_up(incl, o); if (lane >= o) incl += t; }
            const unsigned excl = incl - s;
            if (incl >= need && excl < need) {
                unsigned c = excl; int bin = b0 + 3;
                if (c + h4.w >= need) bin = b0 + 3; else { c += h4.w; if (c + h4.z >= need) bin = b0 + 2; else { c += h4.z; if (c + h4.y >= need) bin = b0 + 1; else { c += h4.y; bin = b0; } } }
                misc[0] = prefix | ((unsigned)bin << shift); misc[1] = need - c;
            }
        }
        __syncthreads();
        prefix = misc[0]; need = misc[1];
        __syncthreads();
    }
}
__device__ __forceinline__ void dsa_tables(const Ctx& F) {
    LAS int* bkt = (LAS int*)(F.lds + ds::O_BKT); LAS float* rb = (LAS float*)(F.lds + ds::O_RB);
    if (F.tid < 128) { const int dd = F.tid; int bk = dd;
        if (dd >= 16) { const int lg = 16 + (int)(logf((float)dd / 16.0f) / 2.0794415416798357f * 16.0f); bk = lg < 31 ? lg : 31; }
        bkt[dd] = bk; }
    if (F.tid < 256) rb[F.tid] = F.in[11][F.tid];
    __syncthreads();
}
__device__ __forceinline__ void dsa_row(const Ctx& F, int b, int t) {
    using namespace ds;
    const int tid = F.tid, lane = F.lane, wave = F.wave;
    LAS unsigned char* L = F.lds;
    LAS unsigned* keys = (LAS unsigned*)(L + O_KEYS); LAS unsigned* hist = (LAS unsigned*)(L + O_HIST); LAS unsigned* misc = (LAS unsigned*)(L + O_MISC);
    LAS float* qs = (LAS float*)(L + O_Q); LAS float* lg = (LAS float*)(L + O_LG); LAS int* sel = (LAS int*)(L + O_SEL);
    LAS int* bkt = (LAS int*)(L + O_BKT); LAS float* rb = (LAS float*)(L + O_RB);
    const size_t row = (size_t)b * SEQ + t; const int n = t + 1;
    const unsigned short* IQ = (const unsigned short*)(F.ws + WS_IQ); const unsigned short* IKN = (const unsigned short*)(F.ws + WS_IKN);
    const float* IKW = (const float*)(F.ws + WS_IKW); const bf16* AQ = (const bf16*)(F.ws + WS_AQ); const bf16* KV = (const bf16*)(F.ws + WS_KV);
    bf16* OB = (bf16*)(F.ws + WS_OB);
    {
        const int head = tid & 7;
        h8 qh[8];
#pragma unroll
        for (int j = 0; j < 8; ++j) qh[j] = *(const h8*)(IQ + row * 512 + head * 64 + 8 * j);
        const float wh = IKW[row * 128 + 64 + head] * 0.35355339059327373f;
        for (int s0 = 0; s0 < n; s0 += 64) {
            const int s = s0 + (tid >> 3); float v = 0.f;
            if (s < n) {
                const unsigned short* kp = IKN + ((size_t)b * SEQ + s) * 64; float dot = 0.f;
#pragma unroll
                for (int j = 0; j < 8; ++j) { const h8 kk = *(const h8*)(kp + 8 * j);
                    dot = __builtin_amdgcn_fdot2((h2){qh[j][0], qh[j][1]}, (h2){kk[0], kk[1]}, dot, false);
                    dot = __builtin_amdgcn_fdot2((h2){qh[j][2], qh[j][3]}, (h2){kk[2], kk[3]}, dot, false);
                    dot = __builtin_amdgcn_fdot2((h2){qh[j][4], qh[j][5]}, (h2){kk[4], kk[5]}, dot, false);
                    dot = __builtin_amdgcn_fdot2((h2){qh[j][6], qh[j][7]}, (h2){kk[6], kk[7]}, dot, false); }
                v = wh * fmaxf(dot, 0.f);
            }
            v += __shfl_xor(v, 1); v += __shfl_xor(v, 2); v += __shfl_xor(v, 4);
            if (head == 0 && s < n) keys[s] = pack_key(v, s);
        }
    }
    __syncthreads();
    unsigned thr = 0u;
    if (n > 256) { block_select256(keys, n, hist, misc, tid, lane, wave); thr = misc[0]; }
    __syncthreads();
    {
        int cnt = 0;
#pragma unroll 1
        for (int i = 0; i < 16; ++i) { const int idx = wave * 1024 + i * 64 + lane; const bool keep = idx < n && keys[idx] >= thr;
            cnt += __builtin_popcountll(__ballot(keep)); }
        if (lane == 0) misc[8 + wave] = (unsigned)cnt;
        __syncthreads();
        int off = 0;
        for (int ww = 0; ww < wave; ++ww) off += (int)misc[8 + ww];
#pragma unroll 1
        for (int i = 0; i < 16; ++i) { const int idx = wave * 1024 + i * 64 + lane; const unsigned k = idx < n ? keys[idx] : 0u; const bool keep = idx < n && k >= thr;
            const unsigned long long bal = __ballot(keep);
            if (keep) sel[off + __builtin_popcountll(bal & ((1ull << lane) - 1ull))] = 8191 - (int)(k & 8191u);
            off += __builtin_popcountll(bal); }
    }
    const int nsel = n < 256 ? n : 256;
    { const int hd = tid >> 6, dd = tid & 63; qs[((hd >> 2) * 64 + dd) * 4 + (hd & 3)] = bf2f(AQ[row * 512 + tid]); }
    __syncthreads();
    {
        const int j = tid & 255, grp = tid >> 8;
        if (j < nsel) {
            const int sidx = sel[j]; const bf16* kp = KV + ((size_t)b * SEQ + sidx) * 256 + grp * 64;
            f32x4 a = (f32x4){0.f, 0.f, 0.f, 0.f};
#pragma unroll 1
            for (int c = 0; c < 8; ++c) { const v4u kk = *(const v4u*)(kp + 8 * c);
                const float kf[8] = {bflo(kk.x), bfhi(kk.x), bflo(kk.y), bfhi(kk.y), bflo(kk.z), bfhi(kk.z), bflo(kk.w), bfhi(kk.w)};
#pragma unroll
                for (int e = 0; e < 8; ++e) a += *(const LAS f32x4*)(qs + (grp * 64 + 8 * c + e) * 4) * kf[e]; }
            const float a0 = a[0], a1 = a[1], a2 = a[2], a3 = a[3];
            const int dist = t - sidx; const int bk = dist < 128 ? bkt[dist] : 31;
            lg[(grp * 4 + 0) * 256 + j] = a0 + rb[bk * 8 + grp * 4 + 0]; lg[(grp * 4 + 1) * 256 + j] = a1 + rb[bk * 8 + grp * 4 + 1];
            lg[(grp * 4 + 2) * 256 + j] = a2 + rb[bk * 8 + grp * 4 + 2]; lg[(grp * 4 + 3) * 256 + j] = a3 + rb[bk * 8 + grp * 4 + 3];
        }
    }
    __syncthreads();
    {
        float v[4]; float mx = -3.0e38f;
#pragma unroll
        for (int i = 0; i < 4; ++i) { const int j = lane + 64 * i; v[i] = j < nsel ? lg[wave * 256 + j] : -3.0e38f; mx = fmaxf(mx, v[i]); }
#pragma unroll
        for (int o = 1; o < 64; o <<= 1) mx = fmaxf(mx, __shfl_xor(mx, o));
        float sm = 0.f;
#pragma unroll
        for (int i = 0; i < 4; ++i) { const int j = lane + 64 * i; v[i] = j < nsel ? __expf(v[i] - mx) : 0.f; sm += v[i]; }
        sm = wave_sum(sm); const float inv = 1.0f / sm;
#pragma unroll
        for (int i = 0; i < 4; ++i) { const int j = lane + 64 * i; lg[wave * 256 + j] = v[i] * inv; }
    }
    __syncthreads();
    {
        const int e = tid & 127, grp = e >> 6, r = tid >> 7, head = grp * 4 + r; float acc = 0.f;
        const bf16* vp = KV + (size_t)b * SEQ * 256 + 128 + e;
        for (int j = 0; j < nsel; ++j) acc += lg[head * 256 + j] * bf2f(vp[(size_t)sel[j] * 256]);
        OB[row * 512 + head * 64 + (e & 63)] = (bf16)f2bf(acc);
    }
    __syncthreads();
}
#endif
__device__ __forceinline__ void fill_zero_bf16(const Ctx& F, bf16* p, size_t nelem) {
    v4u* q = (v4u*)p; const size_t n16 = nelem / 8;
    for (size_t i = (size_t)F.bid * NTHR + F_TID; i < n16; i += (size_t)F.G * NTHR) q[i] = (v4u){0u, 0u, 0u, 0u};
}
#ifndef STAGGER7
#define STAGGER7 0
#endif
#ifndef ALIGN7
#define ALIGN7 1
#endif
#ifndef ALIGN1
#define ALIGN1 1
#endif
#ifndef XBAR_PROBE
#define XBAR_PROBE 0
#endif
#ifndef P6_REP
#define P6_REP 1
#endif
#ifndef P5_REP
#define P5_REP 1
#endif
#ifndef P3_REP
#define P3_REP 1
#endif
#ifndef P1_REP
#define P1_REP 1
#endif
#ifndef P9_REP
#define P9_REP 1
#endif
#ifndef HG_REP
#define HG_REP 1
#endif
#ifndef P0_REP
#define P0_REP 1
#endif
#ifndef P2_REP
#define P2_REP 1
#endif
#ifndef P8_REP
#define P8_REP 1
#endif
#ifndef DSA_REP
#define DSA_REP 1
#endif
constexpr int LW_PER_UNIT = 8;
static_assert(LW_ITEMS % LW_PER_UNIT == 0, "filler units");
#ifndef P4_REP
#define P4_REP 1
#endif
__device__ __forceinline__ void p4_mixers(const Ctx& F, const int qset) {
    LAS unsigned* misc = (LAS unsigned*)(F.lds + MISC_OFF);
#if 0
#else
    dsa_tables(F);
    gu32* qbase = (gu32*)(F.ws + WS_CTL) + CW_Q + 512 * qset;
    const unsigned pb = xb_xcc_id() & 3u;
    if (F_TID == 0) misc[5] = 0u;
    for (;;) {
        if (F_TID == 0) {
            unsigned st = misc[5], kind = 0xffffffffu, val = 0u;
            while (st < 6u) {
                const unsigned qi = st < 4u ? 1u + ((pb + st) & 3u) : (st == 4u ? 0u : 5u);
                const unsigned q = __hip_atomic_fetch_add(qbase + 64 * qi, 1u, __ATOMIC_RELAXED, __HIP_MEMORY_SCOPE_AGENT);
                if (q < (qi == 0u ? (unsigned)HG_UNITS : (qi == 5u ? (unsigned)(LW_ITEMS / LW_PER_UNIT) : 128u))) { kind = qi; val = q; break; }
                ++st;
            }
            misc[5] = st; misc[4] = kind; misc[6] = val;
        }
        __syncthreads();
        int zofs = 0; asm volatile("" : "+v"(zofs));
        const LAS unsigned* mq = (const LAS unsigned*)(F.lds + MISC_OFF + zofs);
        const unsigned kind = __builtin_amdgcn_readfirstlane(mq[4]), val = __builtin_amdgcn_readfirstlane(mq[6]);
        __syncthreads();
        if (kind == 0xffffffffu) break;
        if (kind == 5u) {
            for (int i = 0; i < LW_PER_UNIT / NWAVES; ++i) late_weight_item(F, (int)val * LW_PER_UNIT + i * NWAVES + F.wave);
            continue;
        }
        if (kind == 0u) {
#if !DBG_SKIP_HGRN
            for (int hrep = 0; hrep < HG_REP; ++hrep) hgrn_segment<2>(F, (int)val % (HG_UNITS / HG_NSEG), HG_NSEG - 1 - (int)val / (HG_UNITS / HG_NSEG));
#endif
            continue;
        }
        for (int rep = 0; rep < DSA_REP; ++rep) dsa_unit(F, (int)kind - 1, 127 - (int)val);
    }
#endif
}

__global__ void __launch_bounds__(NTHR, 2) mk_fwd(Args args) {
    extern __shared__ __attribute__((aligned(16))) unsigned char lds_raw[];
    Ctx F;
    F.lds = (LAS unsigned char*)lds_raw; F.wave = __builtin_amdgcn_readfirstlane((int)threadIdx.x >> 6);
    F.G = gridDim.x; F.bid = blockIdx.x; F.in = args.in; F.out = args.out; F.ws = args.ws;
    volatile LAS unsigned* MISC = (volatile LAS unsigned*)(F.lds + MISC_OFF);
    if (F_TID < 64) MISC[F_TID] = 0u;
    __syncthreads();
    const int lo = args.ph_lo, hi = args.ph_hi;
    unsigned* barw = (unsigned*)(F.ws + WS_CTL) + CW_BAR + (MK_N_LAUNCHES == 1 ? 0 : 0);
    XcdBarrier bar; bar.bar = barw; bar.x = 0; bar.st = nullptr;
    if (hi - lo > 1) bar = xcd_barrier_post(barw, MISC, F_TID == 0);
#define IN(k) (lo <= (k) && (k) < hi)
#ifdef ONLYP
#define PH_ON(k) ((k) == ONLYP)
#else
#define PH_ON(k) true
#endif
#define SEAM(k) do { if (IN(k) && IN((k) + 1)) xcd_barrier(bar, F_TID == 0); } while (0)

    if (PH_ON(0) && IN(0)) { for (int rep = 0; rep < P0_REP; ++rep) p0_prologue(F); } SEAM(0);
    if (PH_ON(1) && IN(1)) {
        pg8::Gemm g{(const pg8::bf16_t*)(F.ws + WS_HM), (const pg8::bf16_t*)(F.ws + WS_WIN), M, NPROJ, DM}; pg8::StaticOrder S; S.init(M, NPROJ, F.G, F.bid);
        epi::EpiProj E{F.ws};
        for (int rep = 0; rep < P1_REP; ++rep) pg8::gemm_phase<epi::EpiProj, pg8::StaticOrder, (ALIGN1 != 0), true>(F.lds, g, S, E, F.wave);
    } SEAM(1);
    if (PH_ON(2) && IN(2)) { for (int rep = 0; rep < P2_REP; ++rep) { p2_norms(F); for (int u = F.bid; u < HG_UNITS; u += F.G) hgrn_segment<1>(F, u / HG_NSEG, u % HG_NSEG); } }
    if (PH_ON(3) && IN(3)) {
        pg8::Gemm g{(const pg8::bf16_t*)(F.ws + WS_CQN), (const pg8::bf16_t*)(F.ws + WS_WQI), M, 1024, 256}; pg8::StaticOrder S; S.init(M, 1024, F.G, F.bid);
        epi::EpiQI E{F.ws};
        for (int rep = 0; rep < P3_REP; ++rep) pg8::gemm_phase<epi::EpiQI, pg8::StaticOrder, true, true>(F.lds, g, S, E, F.wave);
    } SEAM(3);
#if XBAR_PROBE > 0
    for (int i = 0; i < XBAR_PROBE; ++i) xcd_barrier(bar, F_TID == 0);
#endif
    if (PH_ON(4) && IN(4)) { p4_mixers(F, 0);
#if P4_REP > 1
        xcd_barrier(bar, F_TID == 0); p4_mixers(F, 1);
#endif
    } SEAM(4);
    if (PH_ON(5) && IN(5)) {
        pg8::Gemm g{(const pg8::bf16_t*)((unsigned char*)F.out + OAB_OFF), (const pg8::bf16_t*)(F.ws + WS_WMH), M, 1024, 1024}; pg8::StaticOrder S; S.init(M, 1024, F.G, F.bid);
        epi::EpiMixM E{F.ws};
        for (int rep = 0; rep < P5_REP; ++rep) pg8::gemm_phase<epi::EpiMixM, pg8::StaticOrder, true, true>(F.lds, g, S, E, F.wave);
    } SEAM(5);
    if (PH_ON(6) && IN(6)) {
        pg8::Gemm g{(const pg8::bf16_t*)(F.ws + WS_MIX), (const pg8::bf16_t*)(F.ws + WS_WO), M, 1024, 1024}; pg8::StaticOrder S; S.init(M, 1024, F.G, F.bid);
        epi::EpiWo E{(const pg8::bf16_t*)(F.ws + WS_HM), (const float*)(F.ws + WS_RMS), (pg8::bf16_t*)(F.ws + WS_XG), (float*)(F.ws + WS_CTL) + CW_ROWSS};
#if P6_REP > 1
        { epi::EpiWo E2{(const pg8::bf16_t*)(F.ws + WS_HM), (const float*)(F.ws + WS_RMS), (pg8::bf16_t*)(F.ws + WS_XG), (float*)(F.ws + WS_QH)}; pg8::gemm_phase<epi::EpiWo, pg8::StaticOrder, true, true>(F.lds, g, S, E2, F.wave); }
#endif
        pg8::gemm_phase<epi::EpiWo, pg8::StaticOrder, true, true>(F.lds, g, S, E, F.wave);
    } SEAM(6);
    if (PH_ON(7) && IN(7)) {
        pg8::Gemm g{(const pg8::bf16_t*)(F.ws + WS_XG), (const pg8::bf16_t*)(F.ws + WS_WMI), M, DFF, 1024}; pg8::StaticOrder S; S.init(M, DFF, F.G, F.bid);
        epi::EpiRelu2 E{(pg8::bf16_t*)(F.ws + WS_HID), (const float*)(F.ws + WS_CTL) + CW_ROWSS};
#if STAGGER7 > 0
        { const int grp = (F.bid >> 3) & 3; for (int i = 0; i < grp * STAGGER7; ++i) __builtin_amdgcn_s_sleep(32); }
#endif
        for (int rep = 0; rep < P9_REP; ++rep) pg8::gemm_phase<epi::EpiRelu2, pg8::StaticOrder, (ALIGN7 != 0), true>(F.lds, g, S, E, F.wave);
    } SEAM(7);
    if (PH_ON(8) && IN(8)) {
        pg8::Gemm g{(const pg8::bf16_t*)(F.ws + WS_HID), (const pg8::bf16_t*)(F.ws + WS_WMO), M, 1024, DFF}; pg8::StaticOrder S; S.init(M, 1024, F.G, F.bid);
        if (args.fuse) {
            epi::EpiFinal E{(const pg8::bf16_t*)(F.ws + WS_XG), F.out, F.in[17], (float*)(F.ws + WS_CTL) + CW_ROWSS2, (unsigned*)(F.ws + WS_CTL) + CW_PCNT};
            pg8::gemm_phase<epi::EpiFinal, pg8::StaticOrder, true, true>(F.lds, g, S, E, F.wave);
        } else {
            epi::EpiResid E{(const pg8::bf16_t*)(F.ws + WS_XG), F.out};
            pg8::gemm_phase<epi::EpiResid, pg8::StaticOrder, true, true>(F.lds, g, S, E, F.wave);
        }
    }
    if (!args.fuse) { SEAM(8); if (PH_ON(9) && IN(9)) { p11_final(F); } }
#undef IN
#undef SEAM
}

extern "C" void kernel_launch(void* const* d_in, const int* in_sizes, int n_in, void* d_out, int out_size, void* d_ws, size_t ws_size, hipStream_t stream) {
    static int grid = 0;
    if (grid == 0) {
        if (n_in != 18 || in_sizes[0] != M * DM || out_size != M * DM || ws_size < WS_END) {
            fprintf(stderr, "kernel_launch: unexpected shapes (n_in %d, in0 %d, out %d, ws %zu); nothing launched\n", n_in, n_in > 0 ? in_sizes[0] : -1, out_size, ws_size); grid = -1; return; }
        int dev = 0, cus = 0, per_cu = 0;
        if (hipGetDevice(&dev) != hipSuccess || hipDeviceGetAttribute(&cus, hipDeviceAttributeMultiprocessorCount, dev) != hipSuccess) { grid = -1; return; }
        if (hipFuncSetAttribute((const void*)mk_fwd, hipFuncAttributeMaxDynamicSharedMemorySize, LDS_BYTES) != hipSuccess) { fprintf(stderr, "kernel_launch: hipFuncSetAttribute failed\n"); grid = -1; return; }
        if (hipOccupancyMaxActiveBlocksPerMultiprocessor(&per_cu, (const void*)mk_fwd, NTHR, LDS_BYTES) != hipSuccess || per_cu < 1) {
            fprintf(stderr, "kernel_launch: occupancy query reports %d workgroups per CU\n", per_cu); }
        (void)hipGetLastError();
        grid = cus;
    }
    if (grid < 0) return;
    if (hipMemsetAsync((char*)d_ws + WS_CTL, 0, CTL_ZERO_BYTES, stream) != hipSuccess) return;
    Args a{};
    for (int i = 0; i < 18; ++i) a.in[i] = (const float*)d_in[i];
    a.out = (float*)d_out; a.ws = (unsigned char*)d_ws;
#if MK_N_LAUNCHES == 1
    a.ph_lo = 0; a.ph_hi = NPHASE;
    a.fuse = (MK_N_LAUNCHES == 1 && (grid == 256 || grid == 512)) ? 1 : 0;
    hipLaunchKernelGGL(mk_fwd, dim3(grid), dim3(NTHR), LDS_BYTES, stream, a);
#else
    for (int p = 0; p < NPHASE; ++p) { a.ph_lo = p; a.ph_hi = p + 1; hipLaunchKernelGGL(mk_fwd, dim3(grid), dim3(NTHR), LDS_BYTES, stream, a); }
#endif
}
```
